# Optimizing an MI355X kernel written in HIP

```python
import math
import jax, jax.numpy as jnp
from jax import lax
import numpy as np

D_MODEL = 1024
BATCH = 8
SEQ = 4096
DEPTH = 4

P_DIM = 256
D_FF = 2816
ML_HEADS = 4
ML_QK_DIM = 64
ML_V_DIM = 128
ML_CHUNK = 64
SW_Q_HEADS = 8
SW_KV_HEADS = 2
SW_HEAD_DIM = 64
WINDOW = 128
REL_BUCKETS = 32
REL_MAX_DIST = 128
EPS = 1e-6

ML_QK_W = ML_HEADS * ML_QK_DIM
ML_V_W = ML_HEADS * ML_V_DIM
SW_Q_W = SW_Q_HEADS * SW_HEAD_DIM
SW_KV_W = SW_KV_HEADS * SW_HEAD_DIM
SPLITS = (ML_QK_W, ML_QK_W, ML_V_W, ML_V_W, ML_HEADS, ML_HEADS, SW_Q_W, SW_KV_W, SW_KV_W, D_MODEL, D_MODEL)
D_IN = 2 * ML_QK_W + 2 * ML_V_W + 2 * ML_HEADS + SW_Q_W + 2 * SW_KV_W + 2 * D_MODEL

kernel_name = "hybrid_mlstm_swa_sink_macaron"


def rmsnorm(x, g):
    xf = x.astype(jnp.float32)
    y = xf * lax.rsqrt(jnp.mean(xf * xf, axis=-1, keepdims=True) + EPS)
    return (y * g.astype(jnp.float32)).astype(x.dtype)


def swiglu_ffn(x, wi, wo):
    g, u = jnp.split(x @ wi, 2, axis=-1)
    return (jax.nn.silu(g) * u) @ wo


def t5_bucket(dist):
    max_exact = REL_BUCKETS // 2
    d = np.maximum(dist, 0)
    large = max_exact + (np.log(np.maximum(d, 1) / max_exact) / np.log(REL_MAX_DIST / max_exact)
                         * (REL_BUCKETS - max_exact)).astype(np.int32)
    large = np.minimum(large, REL_BUCKETS - 1)
    return np.where(d < max_exact, d, large).astype(np.int32)


def mlstm_chunkwise(q, k, v, i_pre, f_pre):
    B, S, H, dk = q.shape
    dv = v.shape[-1]
    L = ML_CHUNK
    NC = S // L
    f32 = jnp.float32
    qc = q.astype(f32).reshape(B, NC, L, H, dk)
    kc = (k.astype(f32) / math.sqrt(dk)).reshape(B, NC, L, H, dk)
    vc = v.astype(f32).reshape(B, NC, L, H, dv)
    log_i = jnp.swapaxes(i_pre.astype(f32).reshape(B, NC, L, H), 2, 3)
    log_f = jnp.swapaxes(jax.nn.log_sigmoid(f_pre.astype(f32)).reshape(B, NC, L, H), 2, 3)
    b = jnp.cumsum(log_f, axis=-1)
    g = b[..., -1]
    a = g[..., None] - b + log_i
    m_loc = jnp.max(a, axis=-1)
    w = jnp.exp(a - m_loc[..., None])
    C_loc = jnp.einsum('bnhl,bnlhk,bnlhv->bnhkv', w, kc, vc)
    n_loc = jnp.einsum('bnhl,bnlhk->bnhk', w, kc)

    def step(carry, xs):
        C, n, m = carry
        g_c, m_c, C_c, n_c = xs
        m_new = jnp.maximum(g_c + m, m_c)
        s_old = jnp.exp(g_c + m - m_new)
        s_new = jnp.exp(m_c - m_new)
        C_new = s_old[..., None, None] * C + s_new[..., None, None] * C_c
        n_new = s_old[..., None] * n + s_new[..., None] * n_c
        return (C_new, n_new, m_new), (C, n, m)

    init = (jnp.zeros((B, H, dk, dv), f32), jnp.zeros((B, H, dk), f32), jnp.zeros((B, H), f32))
    xs = (jnp.moveaxis(g, 1, 0), jnp.moveaxis(m_loc, 1, 0), jnp.moveaxis(C_loc, 1, 0), jnp.moveaxis(n_loc, 1, 0))
    _, (C_prev, n_prev, m_prev) = lax.scan(step, init, xs)
    C_prev = jnp.moveaxis(C_prev, 0, 1)
    n_prev = jnp.moveaxis(n_prev, 0, 1)
    m_prev = jnp.moveaxis(m_prev, 0, 1)

    causal = jnp.tril(jnp.ones((L, L), dtype=bool))
    D = b[..., :, None] - b[..., None, :] + log_i[..., None, :]
    D = jnp.where(causal, D, -jnp.inf)
    e = b + m_prev[..., None]
    m_t = jnp.maximum(jnp.max(D, axis=-1), e)
    W = jnp.exp(D - m_t[..., None]) * jnp.einsum('bnthd,bnshd->bnhts', qc, kc)
    s_inter = jnp.exp(e - m_t)
    num = (jnp.einsum('bnhts,bnshv->bnthv', W, vc)
           + jnp.swapaxes(s_inter, 2, 3)[..., None] * jnp.einsum('bnthd,bnhdv->bnthv', qc, C_prev))
    den = jnp.sum(W, axis=-1) + s_inter * jnp.einsum('bnthd,bnhd->bnht', qc, n_prev)
    denom = jnp.maximum(jnp.abs(den), jnp.exp(-m_t))
    h = num / jnp.swapaxes(denom, 2, 3)[..., None]
    return h.reshape(B, S, H, dv).astype(q.dtype)


def swa_sink_attention(q, k, v, q_gain, k_gain, sinks, rel_bias):
    B, S, Hq, d = q.shape
    Hkv = k.shape[2]
    G = Hq // Hkv
    Wn = WINDOW
    NB = S // Wn
    f32 = jnp.float32
    q = rmsnorm(q, q_gain)
    k = rmsnorm(k, k_gain)
    qb = q.astype(f32).reshape(B, NB, Wn, Hkv, G, d) * (d ** -0.5)
    kb = k.astype(f32).reshape(B, NB, Wn, Hkv, d)
    vb = v.astype(f32).reshape(B, NB, Wn, Hkv, d)
    shift = lambda t: jnp.concatenate([jnp.zeros_like(t[:, :1]), t[:, :-1]], axis=1)
    kk = jnp.concatenate([shift(kb), kb], axis=2)
    vv = jnp.concatenate([shift(vb), vb], axis=2)
    logits = jnp.einsum('bnqkgd,bnskd->bnkgqs', qb, kk)
    dist = np.arange(Wn)[:, None] + Wn - np.arange(2 * Wn)[None, :]
    in_window = (dist >= 0) & (dist < Wn)
    bias = rel_bias.astype(f32)[t5_bucket(dist)]
    bias = jnp.transpose(bias, (2, 0, 1)).reshape(Hkv, G, Wn, 2 * Wn)
    key_pos = np.arange(NB)[:, None] * Wn - Wn + np.arange(2 * Wn)[None, :]
    valid = in_window[None] & (key_pos >= 0)[:, None, :]
    logits = jnp.where(valid[None, :, None, None], logits + bias, -jnp.inf)
    sink = sinks.astype(f32).reshape(Hkv, G)[None, None, :, :, None, None]
    m = jnp.maximum(jnp.max(logits, axis=-1, keepdims=True), sink)
    pr = jnp.exp(logits - m)
    denom = jnp.sum(pr, axis=-1, keepdims=True) + jnp.exp(sink - m)
    out = jnp.einsum('bnkgqs,bnskd->bnqkgd', pr / denom, vv)
    return out.reshape(B, S, Hq * d).astype(q.dtype)


def setup_inputs(seed: int = 0) -> dict:
    key = jax.random.key(seed)
    ks = jax.random.split(key, 24)
    f32 = jnp.float32
    nrm = lambda k, shape, fan_in: jax.random.normal(k, shape, f32) * (fan_in ** -0.5)
    gain = lambda k, shape: 1.0 + 0.05 * jax.random.normal(k, shape, f32)
    return {
        "x": jax.random.normal(ks[0], (BATCH, SEQ, D_MODEL), f32),
        "p": jax.random.normal(ks[1], (DEPTH, BATCH, SEQ, P_DIM), f32),
        "ffn1_norm": gain(ks[2], (DEPTH, D_MODEL)),
        "ffn1_wi": nrm(ks[3], (DEPTH, D_MODEL, 2 * D_FF), D_MODEL),
        "ffn1_wo": nrm(ks[4], (DEPTH, D_FF, D_MODEL), D_FF),
        "mix_norm": gain(ks[5], (DEPTH, D_MODEL)),
        "w_in": nrm(ks[6], (DEPTH, D_MODEL, D_IN), D_MODEL),
        "b_igate": 0.1 * jax.random.normal(ks[7], (DEPTH, ML_HEADS), f32),
        "b_fgate": jnp.linspace(3.0, 6.0, ML_HEADS, dtype=f32)[None, :] + 0.1 * jax.random.normal(ks[8], (DEPTH, ML_HEADS), f32),
        "ml_out_norm": gain(ks[9], (DEPTH, ML_HEADS, ML_V_DIM)),
        "q_norm": gain(ks[10], (DEPTH, SW_HEAD_DIM)),
        "k_norm": gain(ks[11], (DEPTH, SW_HEAD_DIM)),
        "sinks": 0.5 * jax.random.normal(ks[12], (DEPTH, SW_Q_HEADS), f32),
        "rel_bias": 0.5 * jax.random.normal(ks[13], (REL_BUCKETS, SW_Q_HEADS), f32),
        "w_a": nrm(ks[14], (DEPTH, ML_V_W, D_MODEL), ML_V_W),
        "w_b": nrm(ks[15], (DEPTH, SW_Q_W, D_MODEL), SW_Q_W),
        "w_out": nrm(ks[16], (DEPTH, D_MODEL, D_MODEL), D_MODEL),
        "ffn2_norm": gain(ks[17], (DEPTH, D_MODEL)),
        "ffn2_wi": nrm(ks[18], (DEPTH, D_MODEL, 2 * D_FF), D_MODEL),
        "ffn2_wo": nrm(ks[19], (DEPTH, D_FF, D_MODEL), D_FF),
        "ple_norm": gain(ks[20], (DEPTH, D_MODEL)),
        "w_ple_gate": nrm(ks[21], (DEPTH, D_MODEL, D_MODEL), D_MODEL),
        "w_ple": nrm(ks[22], (DEPTH, P_DIM, D_MODEL), P_DIM),
    }


def reference(x, p, ffn1_norm, ffn1_wi, ffn1_wo, mix_norm, w_in, b_igate, b_fgate, ml_out_norm,
              q_norm, k_norm, sinks, rel_bias, w_a, w_b, w_out, ffn2_norm, ffn2_wi, ffn2_wo,
              ple_norm, w_ple_gate, w_ple):
    B, S, _ = x.shape
    offsets = [int(o) for o in np.cumsum(SPLITS)[:-1]]
    for i in range(DEPTH):
        x = x + 0.5 * swiglu_ffn(rmsnorm(x, ffn1_norm[i]), ffn1_wi[i], ffn1_wo[i])
        u = rmsnorm(x, mix_norm[i])
        z = u @ w_in[i]
        mq, mk, mv, mo, mi, mf, sq, sk, sv, ga, gb = jnp.split(z, offsets, axis=-1)
        hA = mlstm_chunkwise(mq.reshape(B, S, ML_HEADS, ML_QK_DIM),
                             mk.reshape(B, S, ML_HEADS, ML_QK_DIM),
                             mv.reshape(B, S, ML_HEADS, ML_V_DIM),
                             mi + b_igate[i], mf + b_fgate[i])
        hA = rmsnorm(hA, ml_out_norm[i]).reshape(B, S, ML_V_W)
        yA = (jax.nn.sigmoid(mo) * hA) @ w_a[i]
        hB = swa_sink_attention(sq.reshape(B, S, SW_Q_HEADS, SW_HEAD_DIM),
                                sk.reshape(B, S, SW_KV_HEADS, SW_HEAD_DIM),
                                sv.reshape(B, S, SW_KV_HEADS, SW_HEAD_DIM),
                                q_norm[i], k_norm[i], sinks[i], rel_bias)
        yB = hB @ w_b[i]
        mixed = jax.nn.sigmoid(ga) * yA + jax.nn.sigmoid(gb) * yB
        x = x + mixed @ w_out[i]
        x = x + 0.5 * swiglu_ffn(rmsnorm(x, ffn2_norm[i]), ffn2_wi[i], ffn2_wo[i])
        gate = jax.nn.sigmoid(rmsnorm(x, ple_norm[i]) @ w_ple_gate[i])
        x = x + gate * (p[i] @ w_ple[i])
    return x
```

```cpp
#define MK_N_LAUNCHES 1
#include <hip/hip_runtime.h>
#include <cstdio>
#include <cstdint>
#include <cmath>
namespace pg8 {
#define PG8_LAS __attribute__((address_space(3)))
typedef unsigned short bf16_t;
typedef short bf16x8 __attribute__((ext_vector_type(8)));
typedef float f32x4 __attribute__((ext_vector_type(4)));
typedef unsigned u32x4 __attribute__((ext_vector_type(4)));
constexpr int BM = 256, BK = 64, HALF = 128, HTB = HALF * BK * 2  , STAGE_BYTES = 8 * HTB, NXCD = 8, WGM = 8;

__host__ __device__ __forceinline__ int lds_byte(int r, int c) { const int st = (r >> 4) * 2 + (c >> 5), rr = r & 15, cc = c & 31, ob = rr * 64 + cc * 2; return st * 1024 + (ob ^ (((ob >> 9) & 1) << 5)); }
__host__ __device__ __forceinline__ void stage_rc(int b, int& R, int& C) { const int st = b / 1024, sb = b % 1024, swz = sb ^ (((sb >> 9) & 1) << 5); R = (st >> 1) * 16 + swz / 64; C = (st & 1) * 32 + (swz % 64) / 2; }
__host__ __device__ __forceinline__ int perm32(int rho) { const int n = rho >> 4, i = rho & 15; return 8 * (i >> 2) + 4 * n + (i & 3); }

struct Unit { int pm, pn; };
struct Gemm { const bf16_t* A; const bf16_t* Bt; int M, N, K; };

struct StaticOrder {
    int nM, nN, nwg, G, c;
    __host__ __device__ void init(int M, int N, int G_, int c_) { nM = M / BM; nN = N / BM; nwg = nM * nN; G = G_; c = c_; }
    __host__ __device__ bool next(int i, Unit& u) const {
        const long L = (long)i * G + c; if (L >= nwg) return false;
        int wgid = (int)L; { const int q = nwg / NXCD, r = nwg % NXCD, xcd = wgid % NXCD, off = wgid / NXCD; wgid = (xcd < r ? xcd * (q + 1) : r * (q + 1) + (xcd - r) * q) + off; }
        const int nig = WGM * nN, gid = wgid / nig, fm = gid * WGM, gsz = (nM - fm) < WGM ? (nM - fm) : WGM;
        u.pm = fm + ((wgid % nig) % gsz); u.pn = (wgid % nig) / gsz; return true;
    }
    __device__ __forceinline__ void a_ready(const Unit&) const {}
    __device__ __forceinline__ void done(const Unit&) const {}
};

__device__ __forceinline__ unsigned cvt_pk_bf16(float lo, float hi) { unsigned r; asm volatile("v_cvt_pk_bf16_f32 %0, %1, %2" : "=v"(r) : "v"(lo), "v"(hi)); return r; }
__device__ __forceinline__ float bf_lo(unsigned w) { return __uint_as_float(w << 16); }
__device__ __forceinline__ float bf_hi(unsigned w) { return __uint_as_float(w & 0xffff0000u); }
__device__ __forceinline__ float sigmoidf_(float v) { return __builtin_amdgcn_rcpf(1.0f + __expf(-v)); }
__device__ __forceinline__ u32x4 pack8(const f32x4 a, const f32x4 b) { u32x4 w; w.x = cvt_pk_bf16(a[0], a[1]); w.y = cvt_pk_bf16(a[2], a[3]); w.z = cvt_pk_bf16(b[0], b[1]); w.w = cvt_pk_bf16(b[2], b[3]); return w; }
constexpr int SSW = 16;
constexpr float RMS_EPS = 1e-6f;
__device__ __forceinline__ float row_rs(const float* ss, int row, int fq) {
    const f32x4 v = *(const f32x4*)(ss + (size_t)row * SSW + fq * 4);
    float s = (v[0] + v[1]) + (v[2] + v[3]);
    s += __shfl_xor(s, 16); s += __shfl_xor(s, 32);
    return 1.0f / sqrtf(s * (1.0f / 1024.0f) + RMS_EPS);
}

struct EpiUp {
    static constexpr bool PERM = true, AFTER_DRAIN = false;
    bf16_t* H; int ldh; const float* ss;
    __device__ __forceinline__ void operator()(const f32x4 (&acc)[2][2][4][2], const Unit& u, int wr, int wc, int fr_in, int fq_in) const {
        int fr = fr_in, fq = fq_in; asm volatile("" : "+v"(fr), "+v"(fq));
        const int row0 = u.pm * BM + wr * 64 + fr, hcol = u.pn * HALF + wc * 32 + 8 * fq;
#pragma unroll
        for (int ai = 0; ai < 2; ++ai)
#pragma unroll
            for (int m = 0; m < 4; ++m) { int row = row0 + ai * HALF + m * 16; asm volatile("" : "+v"(row)); const float r = row_rs(ss, row, fq);
                f32x4 o0, o1;
#pragma unroll
                for (int e = 0; e < 4; ++e) { const float g0 = acc[ai][0][m][0][e] * r, g1 = acc[ai][0][m][1][e] * r, u0 = acc[ai][1][m][0][e] * r, u1 = acc[ai][1][m][1][e] * r;
                    o0[e] = g0 * sigmoidf_(g0) * u0; o1[e] = g1 * sigmoidf_(g1) * u1; }
                *(u32x4*)(H + (size_t)row * ldh + hcol) = pack8(o0, o1); }
    }
};
template <int MODE> struct EpiRes {
    static constexpr bool PERM = true, AFTER_DRAIN = false;
    float* X; bf16_t* XB; float* ssw; float scale; const float* ssr; const bf16_t* PE;
    __device__ __forceinline__ void operator()(const f32x4 (&acc)[2][2][4][2], const Unit& u, int wr, int wc, int fr_in, int fq_in) const {
        int fr = fr_in, fq = fq_in; asm volatile("" : "+v"(fr), "+v"(fq));
        const int row0 = u.pm * BM + wr * 64 + fr, col0 = u.pn * BM + wc * 32 + 8 * fq;
#pragma unroll
        for (int ai = 0; ai < 2; ++ai)
#pragma unroll
            for (int m = 0; m < 4; ++m) { int row = row0 + ai * HALF + m * 16; asm volatile("" : "+v"(row)); float r = 0.f; if (MODE == 1) r = row_rs(ssr, row, fq);
                float q = 0.f;
#pragma unroll
                for (int bj = 0; bj < 2; ++bj) { const size_t off = (size_t)row * 1024 + col0 + bj * HALF;
                    f32x4 x0 = *(const f32x4*)(X + off), x1 = *(const f32x4*)(X + off + 4);
                    f32x4 a0 = acc[ai][bj][m][0], a1 = acc[ai][bj][m][1];
                    if (MODE == 1) { const u32x4 pw = *(const u32x4*)(PE + off);
                        a0[0] = sigmoidf_(a0[0] * r) * bf_lo(pw.x); a0[1] = sigmoidf_(a0[1] * r) * bf_hi(pw.x); a0[2] = sigmoidf_(a0[2] * r) * bf_lo(pw.y); a0[3] = sigmoidf_(a0[3] * r) * bf_hi(pw.y);
                        a1[0] = sigmoidf_(a1[0] * r) * bf_lo(pw.z); a1[1] = sigmoidf_(a1[1] * r) * bf_hi(pw.z); a1[2] = sigmoidf_(a1[2] * r) * bf_lo(pw.w); a1[3] = sigmoidf_(a1[3] * r) * bf_hi(pw.w);
                    } else { a0 = a0 * scale; a1 = a1 * scale; }
                    x0 = x0 + a0; x1 = x1 + a1;
                    *(f32x4*)(X + off) = x0; *(f32x4*)(X + off + 4) = x1;
                    q += (x0[0] * x0[0] + x0[1] * x0[1]) + (x0[2] * x0[2] + x0[3] * x0[3]) + (x1[0] * x1[0] + x1[1] * x1[1]) + (x1[2] * x1[2] + x1[3] * x1[3]);
                    *(u32x4*)(XB + off) = pack8(x0, x1); }
                q += __shfl_xor(q, 16); q += __shfl_xor(q, 32);
                if (fq == 0) ssw[(size_t)row * SSW + u.pn * 4 + wc] = q;
                asm volatile("" ::: "memory"); }
    }
};
struct EpiIn {
    static constexpr bool PERM = true, AFTER_DRAIN = false;
    bf16_t* Z; int ldz; const float* ss; float* IF; const float* bi; const float* bf;
    __device__ __forceinline__ void operator()(const f32x4 (&acc)[2][2][4][2], const Unit& u, int wr, int wc, int fr_in, int fq_in) const {
        int fr = fr_in, fq = fq_in; asm volatile("" : "+v"(fr), "+v"(fq));
        const int row0 = u.pm * BM + wr * 64 + fr, col0 = u.pn * BM + wc * 32 + 8 * fq; const int pn = u.pn;
        if (pn == 17) {
            const f32x4 bi4 = *(const f32x4*)bi, bf4 = *(const f32x4*)bf;
#pragma unroll
            for (int ai = 0; ai < 2; ++ai)
#pragma unroll
                for (int m = 0; m < 4; ++m) { int row = row0 + ai * HALF + m * 16; asm volatile("" : "+v"(row)); const float r = row_rs(ss, row, fq);
                    if (wc == 0 && fq == 0) { *(f32x4*)(IF + (size_t)row * 8) = acc[ai][0][m][0] * r + bi4; *(f32x4*)(IF + (size_t)row * 8 + 4) = acc[ai][0][m][1] * r + bf4; } }
            return;
        }
        const bool sig = (pn == 4) || (pn == 5) || (pn >= 9);
#pragma unroll
        for (int ai = 0; ai < 2; ++ai)
#pragma unroll
            for (int m = 0; m < 4; ++m) { int row = row0 + ai * HALF + m * 16; asm volatile("" : "+v"(row)); const float r = row_rs(ss, row, fq);
#pragma unroll
                for (int bj = 0; bj < 2; ++bj) { f32x4 v0 = acc[ai][bj][m][0] * r, v1 = acc[ai][bj][m][1] * r;
                    if (sig) {
#pragma unroll
                        for (int e = 0; e < 4; ++e) { v0[e] = sigmoidf_(v0[e]); v1[e] = sigmoidf_(v1[e]); } }
                    *(u32x4*)(Z + (size_t)row * ldz + col0 + bj * HALF) = pack8(v0, v1); } }
    }
};
template <int PASS> struct EpiMix {
    static constexpr bool PERM = true, AFTER_DRAIN = false;
    bf16_t* MIX; const bf16_t* Z; int ldz; int goff;
    __device__ __forceinline__ void operator()(const f32x4 (&acc)[2][2][4][2], const Unit& u, int wr, int wc, int fr_in, int fq_in) const {
        int fr = fr_in, fq = fq_in; asm volatile("" : "+v"(fr), "+v"(fq));
        const int row0 = u.pm * BM + wr * 64 + fr, col0 = u.pn * BM + wc * 32 + 8 * fq;
#pragma unroll
        for (int ai = 0; ai < 2; ++ai)
#pragma unroll
            for (int m = 0; m < 4; ++m) { int row = row0 + ai * HALF + m * 16; asm volatile("" : "+v"(row));
#pragma unroll
                for (int bj = 0; bj < 2; ++bj) { const int col = col0 + bj * HALF;
                    const u32x4 gw = *(const u32x4*)(Z + (size_t)row * ldz + goff + col);
                    f32x4 v0 = acc[ai][bj][m][0], v1 = acc[ai][bj][m][1];
                    v0[0] *= bf_lo(gw.x); v0[1] *= bf_hi(gw.x); v0[2] *= bf_lo(gw.y); v0[3] *= bf_hi(gw.y);
                    v1[0] *= bf_lo(gw.z); v1[1] *= bf_hi(gw.z); v1[2] *= bf_lo(gw.w); v1[3] *= bf_hi(gw.w);
                    if (PASS == 1) { const u32x4 tw = *(const u32x4*)(MIX + (size_t)row * 1024 + col);
                        v0[0] += bf_lo(tw.x); v0[1] += bf_hi(tw.x); v0[2] += bf_lo(tw.y); v0[3] += bf_hi(tw.y);
                        v1[0] += bf_lo(tw.z); v1[1] += bf_hi(tw.z); v1[2] += bf_lo(tw.w); v1[3] += bf_hi(tw.w); }
                    *(u32x4*)(MIX + (size_t)row * 1024 + col) = pack8(v0, v1); }
                asm volatile("" ::: "memory"); }
    }
};
struct EpiPlain {
    static constexpr bool PERM = true, AFTER_DRAIN = false;
    bf16_t* O; int ldc;
    __device__ __forceinline__ void operator()(const f32x4 (&acc)[2][2][4][2], const Unit& u, int wr, int wc, int fr_in, int fq_in) const {
        int fr = fr_in, fq = fq_in; asm volatile("" : "+v"(fr), "+v"(fq));
        const int row0 = u.pm * BM + wr * 64 + fr, col0 = u.pn * BM + wc * 32 + 8 * fq;
#pragma unroll
        for (int ai = 0; ai < 2; ++ai)
#pragma unroll
            for (int m = 0; m < 4; ++m) { int row = row0 + ai * HALF + m * 16; asm volatile("" : "+v"(row));
#pragma unroll
                for (int bj = 0; bj < 2; ++bj) *(u32x4*)(O + (size_t)row * ldc + col0 + bj * HALF) = pack8(acc[ai][bj][m][0], acc[ai][bj][m][1]); }
    }
};

template <class Epi, class Sched, bool ALIGN_EPI = false, bool SP2 = false>
__device__ __forceinline__ void gemm_phase(PG8_LAS unsigned char* lds, const Gemm g, const Sched& S, const Epi& E) {
    int tid_l = threadIdx.x; asm volatile("" : "+v"(tid_l));
    const int tid = tid_l, wid = __builtin_amdgcn_readfirstlane(tid >> 6), lane = tid & 63, wr = wid >> 2, wc = wid & 3, fr = lane & 15, fq = lane >> 4;
    const int K = g.K, nt = K / BK;
    unsigned voffA[2], voffB[2];
#pragma unroll
    for (int i = 0; i < 2; ++i) { int R, C; stage_rc(tid * 16 + i * 8192, R, C); const int Rb = Epi::PERM ? ((R & ~31) + perm32(R & 31)) : R;
        voffA[i] = (unsigned)(R * K + C) * 2u; voffB[i] = (unsigned)(Rb * K + C) * 2u; }
    const size_t kstep = (size_t)(BK * 2);
    const size_t hstep = (size_t)HALF * K * 2;
    const size_t tstep = 2 * hstep;
    const unsigned ldsw = (unsigned)wid * 1024u;
    const int aoff = lds_byte(wr * 64 + fr, fq * 8), boff = lds_byte(wc * 32 + fr, fq * 8);
#define PG8_SA(b, h) (((b) * 2 + (h)) * HTB)
#define PG8_SB(b, h) ((4 + (b) * 2 + (h)) * HTB)
#define PG8_STAGE(bufoff, gbase, voff) do { _Pragma("unroll") for (int _i = 0; _i < 2; ++_i) \
        __builtin_amdgcn_global_load_lds((const unsigned*)((const char*)(gbase) + (voff)[_i]), (PG8_LAS unsigned*)(lds + (bufoff) + ldsw + _i * 8192), 16, 0, 0); } while (0)
#define PG8_LDA(dst, b, h) do { _Pragma("unroll") for (int m = 0; m < 4; ++m) _Pragma("unroll") for (int k = 0; k < 2; ++k) dst[m][k] = *(const PG8_LAS bf16x8*)(lds + PG8_SA(b, h) + aoff + m * 2048 + k * 1024); } while (0)
#define PG8_LDB(dst, b, h) do { _Pragma("unroll") for (int n = 0; n < 2; ++n) _Pragma("unroll") for (int k = 0; k < 2; ++k) dst[n][k] = *(const PG8_LAS bf16x8*)(lds + PG8_SB(b, h) + boff + n * 2048 + k * 1024); } while (0)
#define PG8_MMA(ai, bj, At, Bt) do { __builtin_amdgcn_s_setprio(1); _Pragma("unroll") for (int m = 0; m < 4; ++m) _Pragma("unroll") for (int n = 0; n < 2; ++n) _Pragma("unroll") for (int k = 0; k < 2; ++k) \
        acc[ai][bj][m][n] = __builtin_amdgcn_mfma_f32_16x16x32_bf16(Bt[n][k], At[m][k], acc[ai][bj][m][n], 0, 0, 0); __builtin_amdgcn_s_setprio(0); } while (0)
#define PG8_WAIT_V(n) asm volatile("s_waitcnt vmcnt(" #n ")" ::: "memory")
#define PG8_WAIT_L(n) asm volatile("s_waitcnt lgkmcnt(" #n ")" ::: "memory")
#define PG8_BAR __builtin_amdgcn_s_barrier()
#define PG8_SCHED __builtin_amdgcn_sched_barrier(0)
    Unit cur, nxt; int ui = 0;
    if (!S.next(0, cur)) return;
    f32x4 acc[2][2][4][2];
#pragma unroll
    for (int a = 0; a < 2; ++a)
#pragma unroll
        for (int b = 0; b < 2; ++b)
#pragma unroll
            for (int m = 0; m < 4; ++m)
#pragma unroll
                for (int n = 0; n < 2; ++n) acc[a][b][m][n] = (f32x4){0.f, 0.f, 0.f, 0.f};
    bf16x8 At[4][2], B0[2][2], B1[2][2];
    const char* cA = (const char*)g.A + (size_t)cur.pm * tstep; const char* cB = (const char*)g.Bt + (size_t)cur.pn * tstep;
    S.a_ready(cur);
    if constexpr (SP2) {
        PG8_STAGE(PG8_SB(0, 0), cB, voffB); PG8_STAGE(PG8_SB(0, 1), cB + hstep, voffB); PG8_STAGE(PG8_SA(0, 0), cA, voffA); PG8_STAGE(PG8_SA(0, 1), cA + hstep, voffA);
        if (wr == 1) PG8_BAR;
        PG8_WAIT_V(2); PG8_BAR;
        PG8_STAGE(PG8_SB(1, 0), cB + kstep, voffB); PG8_STAGE(PG8_SA(1, 0), cA + kstep, voffA); PG8_STAGE(PG8_SB(1, 1), cB + hstep + kstep, voffB);
        PG8_WAIT_V(6); PG8_BAR;
    } else {
        PG8_STAGE(PG8_SB(0, 0), cB, voffB); PG8_STAGE(PG8_SA(0, 0), cA, voffA); PG8_STAGE(PG8_SB(0, 1), cB + hstep, voffB); PG8_STAGE(PG8_SA(0, 1), cA + hstep, voffA);
        if (wr == 1) PG8_BAR;
        PG8_WAIT_V(4); PG8_BAR;
        PG8_STAGE(PG8_SB(1, 0), cB + kstep, voffB); PG8_STAGE(PG8_SA(1, 0), cA + kstep, voffA); PG8_STAGE(PG8_SB(1, 1), cB + hstep + kstep, voffB);
        PG8_WAIT_V(6); PG8_BAR;
    }
    for (;;) {
        const bool has_next = S.next(ui + 1, nxt);
        const char* nA = has_next ? (const char*)g.A + (size_t)nxt.pm * tstep : cA; const char* nB = has_next ? (const char*)g.Bt + (size_t)nxt.pn * tstep : cB;
        for (int t = 0; t < nt; t += 2) {
            const bool last = (t == nt - 2);
            const char* a1 = cA + (size_t)(t + 1) * kstep;
            const char* a2 = last ? nA : cA + (size_t)(t + 2) * kstep; const char* b2 = last ? nB : cB + (size_t)(t + 2) * kstep;
            const char* a3 = a2 + kstep; const char* b3 = b2 + kstep;
            if (last && has_next) S.a_ready(nxt);
            if constexpr (SP2) {
            PG8_LDB(B0, 0, 0); PG8_LDB(B1, 0, 1); PG8_SCHED; PG8_LDA(At, 0, 0); PG8_STAGE(PG8_SA(1, 1), a1 + hstep, voffA);
            PG8_WAIT_V(8); PG8_WAIT_L(0); PG8_BAR; PG8_MMA(0, 0, At, B0); PG8_MMA(0, 1, At, B1); PG8_BAR; PG8_SCHED;
            PG8_LDA(At, 0, 1); PG8_STAGE(PG8_SB(0, 0), b2, voffB); PG8_STAGE(PG8_SB(0, 1), b2 + hstep, voffB); PG8_STAGE(PG8_SA(0, 0), a2, voffA);
            PG8_WAIT_V(8); PG8_WAIT_L(0); PG8_BAR; PG8_MMA(1, 0, At, B0); PG8_MMA(1, 1, At, B1); PG8_BAR; PG8_SCHED;
            PG8_LDB(B0, 1, 0); PG8_LDB(B1, 1, 1); PG8_SCHED; PG8_LDA(At, 1, 0); PG8_STAGE(PG8_SA(0, 1), a2 + hstep, voffA);
            PG8_WAIT_V(8); PG8_WAIT_L(0); PG8_BAR; PG8_MMA(0, 0, At, B0); PG8_MMA(0, 1, At, B1); PG8_BAR; PG8_SCHED;
            PG8_LDA(At, 1, 1); PG8_STAGE(PG8_SB(1, 0), b3, voffB); PG8_STAGE(PG8_SB(1, 1), b3 + hstep, voffB); PG8_STAGE(PG8_SA(1, 0), a3, voffA);
            PG8_WAIT_V(8); PG8_WAIT_L(0); PG8_BAR; PG8_MMA(1, 0, At, B0); PG8_MMA(1, 1, At, B1); PG8_BAR; PG8_SCHED;
            } else {
            PG8_LDB(B0, 0, 0); PG8_SCHED; PG8_LDA(At, 0, 0); PG8_STAGE(PG8_SA(1, 1), a1 + hstep, voffA);
            PG8_WAIT_L(8); PG8_BAR; PG8_WAIT_L(0); PG8_MMA(0, 0, At, B0); PG8_BAR; PG8_SCHED;
            PG8_LDB(B1, 0, 1); PG8_STAGE(PG8_SB(0, 0), b2, voffB);
            PG8_BAR; PG8_WAIT_L(0); PG8_MMA(0, 1, At, B1); PG8_BAR;
            PG8_LDA(At, 0, 1); PG8_STAGE(PG8_SA(0, 0), a2, voffA);
            PG8_BAR; PG8_WAIT_L(0); PG8_MMA(1, 0, At, B0); PG8_BAR; PG8_SCHED;
            PG8_STAGE(PG8_SB(0, 1), b2 + hstep, voffB);
            PG8_WAIT_V(6); PG8_BAR; PG8_MMA(1, 1, At, B1); PG8_BAR;
            PG8_LDB(B0, 1, 0); PG8_SCHED; PG8_LDA(At, 1, 0); PG8_STAGE(PG8_SA(0, 1), a2 + hstep, voffA);
            PG8_WAIT_L(8); PG8_BAR; PG8_WAIT_L(0); PG8_MMA(0, 0, At, B0); PG8_BAR; PG8_SCHED;
            PG8_LDB(B1, 1, 1); PG8_STAGE(PG8_SB(1, 0), b3, voffB);
            PG8_BAR; PG8_WAIT_L(0); PG8_MMA(0, 1, At, B1); PG8_BAR;
            PG8_LDA(At, 1, 1); PG8_STAGE(PG8_SA(1, 0), a3, voffA);
            PG8_BAR; PG8_WAIT_L(0); PG8_MMA(1, 0, At, B0); PG8_BAR; PG8_SCHED;
            PG8_STAGE(PG8_SB(1, 1), b3 + hstep, voffB);
            PG8_WAIT_V(6); PG8_BAR; PG8_MMA(1, 1, At, B1); PG8_BAR;
            }
        }
        if constexpr (ALIGN_EPI) { if (wr == 0) PG8_BAR; }
        if constexpr (!Epi::AFTER_DRAIN) { E(acc, cur, wr, wc, fr, fq); S.done(cur); }
        if (!has_next) break;
#pragma unroll
        for (int a = 0; a < 2; ++a)
#pragma unroll
            for (int b = 0; b < 2; ++b)
#pragma unroll
                for (int m = 0; m < 4; ++m)
#pragma unroll
                    for (int n = 0; n < 2; ++n) acc[a][b][m][n] = (f32x4){0.f, 0.f, 0.f, 0.f};
        cur = nxt; cA = nA; cB = nB; ++ui;
        if constexpr (ALIGN_EPI) { if (wr == 1) PG8_BAR; }
    }
    PG8_WAIT_V(0);
    if constexpr (!ALIGN_EPI) { if (wr == 0) PG8_BAR; }
    PG8_BAR;
    if constexpr (Epi::AFTER_DRAIN) { E.fused(acc, cur, wr, wc, fr, fq, lds, wid, lane); S.done(cur); }
#undef PG8_SA
#undef PG8_SB
#undef PG8_STAGE
#undef PG8_LDA
#undef PG8_LDB
#undef PG8_MMA
#undef PG8_WAIT_V
#undef PG8_WAIT_L
#undef PG8_BAR
#undef PG8_SCHED
}
}
#define GAS __attribute__((address_space(1)))
#define LAS __attribute__((address_space(3)))
typedef unsigned short bf16;
typedef unsigned v4u __attribute__((ext_vector_type(4)));
typedef float f32x4 __attribute__((ext_vector_type(4)));
typedef short bf16x8 __attribute__((ext_vector_type(8)));
typedef GAS unsigned gu32;
typedef GAS unsigned long long gu64;
#define RLX_AGENT __ATOMIC_RELAXED, __HIP_MEMORY_SCOPE_AGENT
#define LDS_WAIT() asm volatile("s_waitcnt lgkmcnt(0)" ::: "memory")
#define VM_WAIT() asm volatile("s_waitcnt vmcnt(0)" ::: "memory")
__device__ __forceinline__ unsigned long long rt() { return __builtin_amdgcn_s_memrealtime(); }
__device__ __forceinline__ unsigned f2bf(float f) { unsigned u = __builtin_bit_cast(unsigned, f); return (u + 0x7fffu + ((u >> 16) & 1u)) >> 16; }
__device__ __forceinline__ unsigned pk2(float lo, float hi) { return f2bf(lo) | (f2bf(hi) << 16); }

#define XB_TMO      128
#define XB_XCNT(j)  (256  + 64 * (j))
#define XB_XSUB(j)  (1280 + 64 * (j))
#define XB_XGEN(j)  (2304 + 64 * (j))
#define XB_TOP      3328
#define XB_TOPGEN   3392
#define XCD_BAR_WORDS 3456
#define XB_SPIN_CAP (1u << 18)

__device__ __forceinline__ unsigned xb_ld(unsigned* p)              { return __hip_atomic_load(p, __ATOMIC_RELAXED, __HIP_MEMORY_SCOPE_AGENT); }
__device__ __forceinline__ unsigned xb_add(unsigned* p, unsigned v) { return __hip_atomic_fetch_add(p, v, __ATOMIC_RELAXED, __HIP_MEMORY_SCOPE_AGENT); }
__device__ __forceinline__ unsigned xb_xcc_id() { return (unsigned)__builtin_amdgcn_s_getreg((3 << 11) | 20) & 0xFu; }
#define XB_SPIN(cond, bar) do { unsigned _sp = 0; while (cond) { __builtin_amdgcn_s_sleep(1); \
    if ((++_sp & 255u) == 0u) { if (xb_ld(&(bar)[XB_TMO])) break; if (_sp > XB_SPIN_CAP) { atomicAdd(&(bar)[XB_TMO], 1u); break; } } } } while (0)

struct XcdBarrier {
    unsigned* bar; unsigned x;
    volatile LAS unsigned* st;
};

__device__ __forceinline__ XcdBarrier xcd_barrier_post(unsigned* bar, volatile LAS unsigned* st) {
    XcdBarrier b; b.bar = bar; b.x = xb_xcc_id(); b.st = st;
    if (threadIdx.x == 0) (void)xb_add(&bar[XB_XCNT(b.x)], 1u);
    return b;
}
__device__ __forceinline__ void xcd_barrier_complete(unsigned* bar, unsigned x, unsigned& nloc, unsigned& nx) {
    const unsigned G = gridDim.x * gridDim.y * gridDim.z;
    unsigned sum, cnt, mine, sp = 0u;
    for (;;) {
        sum = 0u; cnt = 0u; mine = 0u;
#pragma unroll
        for (unsigned j = 0; j < 16; ++j) { const unsigned c = xb_ld(&bar[XB_XCNT(j)]); sum += c; cnt += (c > 0u) ? 1u : 0u; mine = (j == x) ? c : mine; }
        if (sum == G) break;
        __builtin_amdgcn_s_sleep(1);
        if ((++sp & 255u) == 0u) { if (xb_ld(&bar[XB_TMO])) break; if (sp > XB_SPIN_CAP) { atomicAdd(&bar[XB_TMO], 1u); break; } }
    }
    nloc = mine > 0u ? mine : 1u; nx = cnt > 0u ? cnt : 1u;
}

__device__ __forceinline__ void xcd_barrier(const XcdBarrier& b) {
    asm volatile("s_waitcnt vmcnt(0)" ::: "memory");
    __syncthreads();
    if (threadIdx.x == 0) {
        unsigned* bar = b.bar;
        __builtin_amdgcn_s_waitcnt(0);
        unsigned nloc = b.st[0], nx = b.st[1];
        if (nloc == 0u) { unsigned xo = b.x; asm volatile("" : "+s"(xo)); xcd_barrier_complete(bar, xo, nloc, nx); b.st[0] = nloc; b.st[1] = nx; }
        const unsigned old = xb_add(&bar[XB_XSUB(b.x)], 1u);
        const unsigned gen = old / nloc;
        if (old + 1u == (gen + 1u) * nloc) {
            __builtin_amdgcn_fence(__ATOMIC_RELEASE, "agent");
            asm volatile("s_waitcnt vmcnt(0)" ::: "memory");
            const unsigned og = xb_add(&bar[XB_TOP], 1u);
            const unsigned tg = og / nx;
            if (og + 1u == (tg + 1u) * nx) xb_add(&bar[XB_TOPGEN], 1u);
            else XB_SPIN(xb_ld(&bar[XB_TOPGEN]) == tg, bar);
            __builtin_amdgcn_fence(__ATOMIC_ACQUIRE, "agent");
            xb_add(&bar[XB_XGEN(b.x)], 1u);
            asm volatile("s_waitcnt vmcnt(0)" ::: "memory");
        } else {
            XB_SPIN(xb_ld(&bar[XB_XGEN(b.x)]) == gen, bar);
            __builtin_amdgcn_fence(__ATOMIC_ACQUIRE, "agent");
            asm volatile("s_waitcnt vmcnt(0)" ::: "memory");
        }
    }
    __syncthreads();
}

constexpr int NWAVES = 8;
constexpr int NBATCH = 8, SEQ = 4096, DM = 1024, DEPTH = 4, M = NBATCH * SEQ, PD = 256, FF = 2816, NUP = 2 * FF, DIN = 4360, NIN = 4608;
constexpr int NUNIT_ML = NBATCH * 64 * 4;
constexpr int NUNIT_SW = NBATCH * 32 * 2;
constexpr float EPSF = 1e-6f;
constexpr int ZC_MQ = 0, ZC_MK = 256, ZC_MV = 512, ZC_MO = 1024, ZC_SQ = 1536, ZC_SK = 2048, ZC_SV = 2176, ZC_GA = 2304, ZC_GB = 3328, ZC_IF = 4352;

constexpr size_t MiB = 1u << 20;
constexpr size_t WS_CTL = 0, CTL_ZERO_BYTES = 1 * MiB;
constexpr size_t WS_SSA = 1 * MiB, WS_SSB = 3 * MiB;
constexpr size_t WS_IF = 5 * MiB;
constexpr size_t WS_NST = 6 * MiB;
constexpr size_t WS_GM = 6 * MiB + 512 * 1024;
constexpr size_t WS_BT = 7 * MiB;
constexpr size_t WS_W = 8 * MiB;
constexpr size_t WS_PB = 58 * MiB;
constexpr size_t WS_XB0 = 74 * MiB;
constexpr size_t WS_HA = 138 * MiB;
constexpr size_t WS_HB = 170 * MiB;
constexpr size_t WS_PE = 138 * MiB;
constexpr size_t WS_MIX = 202 * MiB;
constexpr size_t WS_CST = 266 * MiB;
constexpr size_t WS_Z = 330 * MiB;
constexpr size_t WS_H = WS_Z;
constexpr size_t WS_XB1 = WS_Z + 192 * MiB;
constexpr size_t WS_END = 618 * MiB;
constexpr size_t WO_UP1 = 0, WO_DN1 = WO_UP1 + (size_t)NUP * DM, WO_IN = WO_DN1 + (size_t)DM * FF, WO_A = WO_IN + (size_t)NIN * DM, WO_B = WO_A + (size_t)DM * 512,
                 WO_OUT = WO_B + (size_t)DM * 512, WO_UP2 = WO_OUT + (size_t)DM * DM, WO_DN2 = WO_UP2 + (size_t)NUP * DM, WO_PG = WO_DN2 + (size_t)DM * FF, WO_PLE = WO_PG + (size_t)DM * DM,
                 WO_END = WO_PLE + (size_t)DM * PD;
static_assert(WO_END * 2 <= 50 * MiB, "weights fit");
static_assert(WS_Z + (size_t)M * NIN * 2 <= WS_END && WS_H + (size_t)M * FF * 2 <= WS_XB1 && WS_XB1 + (size_t)M * DM * 2 <= WS_END, "ws map");
constexpr int CW_BAR = 4096;
constexpr int NPHASE = 12 * DEPTH;
#ifndef MK_N_LAUNCHES
#define MK_N_LAUNCHES 1
#endif
static_assert((CW_BAR + (MK_N_LAUNCHES) * XCD_BAR_WORDS) * 4 <= (int)CTL_ZERO_BYTES, "barrier words inside the memset region");

constexpr int RING_OFF = 0, RING_BYTES = 131072;
constexpr int LDSCTL_OFF = RING_BYTES, MISC_OFF = LDSCTL_OFF + 320;
constexpr int LDS_BYTES = 147456;

typedef unsigned u32x4 __attribute__((ext_vector_type(4)));
__device__ const unsigned char T5_BUCKET[128] = {0,1,2,3,4,5,6,7,8,9,10,11,12,13,14,15,16,16,16,17,17,18,18,18,19,19,19,20,20,20,20,21,21,21,21,22,22,22,22,22,23,23,23,23,23,23,24,24,24,24,24,24,25,25,25,25,25,25,25,26,26,26,26,26,26,26,26,27,27,27,27,27,27,27,27,27,27,28,28,28,28,28,28,28,28,28,28,29,29,29,29,29,29,29,29,29,29,29,29,30,30,30,30,30,30,30,30,30,30,30,30,30,30,31,31,31,31,31,31,31,31,31,31,31,31,31,31,31};

__device__ __forceinline__ float bflo(unsigned w) { return __uint_as_float(w << 16); }
__device__ __forceinline__ float bfhi(unsigned w) { return __uint_as_float(w & 0xffff0000u); }
__device__ __forceinline__ void unpack8(const u32x4 w, float (&f)[8]) { f[0] = bflo(w.x); f[1] = bfhi(w.x); f[2] = bflo(w.y); f[3] = bfhi(w.y); f[4] = bflo(w.z); f[5] = bfhi(w.z); f[6] = bflo(w.w); f[7] = bfhi(w.w); }
__device__ __forceinline__ u32x4 pack8f(const float (&f)[8]) { u32x4 w; w.x = pk2(f[0], f[1]); w.y = pk2(f[2], f[3]); w.z = pk2(f[4], f[5]); w.w = pk2(f[6], f[7]); return w; }
__device__ __forceinline__ float wave_sum(float v) {
#pragma unroll
    for (int o = 1; o < 64; o <<= 1) v += __shfl_xor(v, o);
    return v;
}
__device__ __forceinline__ float wave_max(float v) {
#pragma unroll
    for (int o = 1; o < 64; o <<= 1) v = fmaxf(v, __shfl_xor(v, o));
    return v;
}
__device__ __forceinline__ float wave_incl_sum(float v, int lane) {
#pragma unroll
    for (int o = 1; o < 64; o <<= 1) { const float t = __shfl_up(v, o); if (lane >= o) v += t; }
    return v;
}
__device__ __forceinline__ float wave_incl_max(float v, int lane) {
#pragma unroll
    for (int o = 1; o < 64; o <<= 1) { const float t = __shfl_up(v, o); if (lane >= o) v = fmaxf(v, t); }
    return v;
}
__device__ __forceinline__ float logsigmoidf_(float x) { return fminf(x, 0.f) - log1pf(expf(-fabsf(x))); }

template <int MAP> __device__ __forceinline__ int cvt_map(int n, int N) {
    if (n >= N) return -1;
    if (MAP == 1) { return n < FF ? ((n >> 7) * 256 + (n & 127)) : (((n - FF) >> 7) * 256 + 128 + ((n - FF) & 127)); }
    if (MAP == 2) { return n < 1536 ? n : (n < 1544 ? (ZC_IF + n - 1536) : n - 8); }
    return n;
}
template <int MAP> __device__ __forceinline__ void cvt_item(const float* W, int K, int N, const float* gain, bf16* WT, LAS float* scr, int item, int lane) {
    const int nblk = (N + 31) / 32, kb = item / nblk, nb = item % nblk, k0 = 64 * kb, n0 = 32 * nb;
    const int nn = n0 + (lane & 31); const bool nv = nn < N;
#pragma unroll 8
    for (int i = 0; i < 32; ++i) { const int kk = 2 * i + (lane >> 5); float w = nv ? W[(size_t)(k0 + kk) * N + nn] : 0.f; if (gain) w *= gain[k0 + kk]; scr[kk * 33 + (lane & 31)] = w; }
    LDS_WAIT(); asm volatile("" ::: "memory");
    const int c = lane & 7;
#pragma unroll
    for (int j = 0; j < 4; ++j) { const int n = (lane >> 3) + 8 * j; const LAS float* s = scr + (8 * c) * 33 + n;
        v4u o; o.x = pk2(s[0 * 33], s[1 * 33]); o.y = pk2(s[2 * 33], s[3 * 33]); o.z = pk2(s[4 * 33], s[5 * 33]); o.w = pk2(s[6 * 33], s[7 * 33]);
        const int dr = cvt_map<MAP>(n0 + n, N);
        if (dr >= 0) *(GAS v4u*)(WT + (size_t)dr * K + k0 + 8 * c) = o; }
    LDS_WAIT(); asm volatile("" ::: "memory");
}

struct Args { const float* in[23]; float* out; unsigned char* ws; int ph_lo, ph_hi, li, pad; };
typedef const __attribute__((address_space(4))) Args* KArgs;
enum { I_X = 0, I_P, I_FFN1_NORM, I_FFN1_WI, I_FFN1_WO, I_MIX_NORM, I_W_IN, I_B_I, I_B_F, I_ML_NORM, I_Q_NORM, I_K_NORM, I_SINKS, I_REL_BIAS, I_W_A, I_W_B, I_W_OUT, I_FFN2_NORM, I_FFN2_WI, I_FFN2_WO, I_PLE_NORM, I_W_PG, I_W_PLE };
#define PHASE_ENTRY(ka) KArgs A = (ka); asm volatile("" : "+s"(A)); int tid = threadIdx.x; asm volatile("" : "+v"(tid)); unsigned char* const ws = A->ws; (void)ws; (void)tid

__device__ __forceinline__ void phase_convert(KArgs ka, int l, LAS unsigned char* lds, int G) {
    PHASE_ENTRY(ka);
    const int lane = tid & 63, wave = tid >> 6;
    LAS float* scr = (LAS float*)(lds + wave * 16384);
    const int gw = blockIdx.x * NWAVES + wave, NGW = G * NWAVES;
    bf16* Wb = (bf16*)(ws + WS_W);
    constexpr int I_UP = (DM / 64) * (NUP / 32), I_DN = (FF / 64) * (DM / 32), I_IN = (DM / 64) * ((DIN + 31) / 32), I_A = (512 / 64) * (DM / 32), I_OUT = (DM / 64) * (DM / 32), I_PLE = (PD / 64) * (DM / 32);
    constexpr int NITEMS = 2 * I_UP + 2 * I_DN + I_IN + 2 * I_A + 2 * I_OUT + I_PLE;
    for (int it = gw; it < NITEMS; it += NGW) {
        int r = it;
        if (r < I_UP) { cvt_item<1>(A->in[I_FFN1_WI] + (size_t)l * DM * NUP, DM, NUP, A->in[I_FFN1_NORM] + l * DM, Wb + WO_UP1, scr, r, lane); continue; } r -= I_UP;
        if (r < I_UP) { cvt_item<1>(A->in[I_FFN2_WI] + (size_t)l * DM * NUP, DM, NUP, A->in[I_FFN2_NORM] + l * DM, Wb + WO_UP2, scr, r, lane); continue; } r -= I_UP;
        if (r < I_DN) { cvt_item<0>(A->in[I_FFN1_WO] + (size_t)l * FF * DM, FF, DM, nullptr, Wb + WO_DN1, scr, r, lane); continue; } r -= I_DN;
        if (r < I_DN) { cvt_item<0>(A->in[I_FFN2_WO] + (size_t)l * FF * DM, FF, DM, nullptr, Wb + WO_DN2, scr, r, lane); continue; } r -= I_DN;
        if (r < I_IN) { cvt_item<2>(A->in[I_W_IN] + (size_t)l * DM * DIN, DM, DIN, A->in[I_MIX_NORM] + l * DM, Wb + WO_IN, scr, r, lane); continue; } r -= I_IN;
        if (r < I_A) { cvt_item<0>(A->in[I_W_A] + (size_t)l * 512 * DM, 512, DM, nullptr, Wb + WO_A, scr, r, lane); continue; } r -= I_A;
        if (r < I_A) { cvt_item<0>(A->in[I_W_B] + (size_t)l * 512 * DM, 512, DM, nullptr, Wb + WO_B, scr, r, lane); continue; } r -= I_A;
        if (r < I_OUT) { cvt_item<0>(A->in[I_W_OUT] + (size_t)l * DM * DM, DM, DM, nullptr, Wb + WO_OUT, scr, r, lane); continue; } r -= I_OUT;
        if (r < I_OUT) { cvt_item<0>(A->in[I_W_PG] + (size_t)l * DM * DM, DM, DM, A->in[I_PLE_NORM] + l * DM, Wb + WO_PG, scr, r, lane); continue; } r -= I_OUT;
        cvt_item<0>(A->in[I_W_PLE] + (size_t)l * PD * DM, PD, DM, nullptr, Wb + WO_PLE, scr, r, lane);
    }
    {
        bf16* wi = Wb + WO_IN + (size_t)(ZC_IF + 8) * DM; const int nz = (NIN - ZC_IF - 8) * DM / 8;
        for (int i = blockIdx.x * 512 + tid; i < nz; i += G * 512) *(GAS v4u*)(wi + (size_t)i * 8) = (v4u){0u, 0u, 0u, 0u};
    }
    {
        const float* pl = A->in[I_P] + (size_t)l * M * PD; bf16* pb = (bf16*)(ws + WS_PB); const int nch = M * PD / 8;
        for (int i = blockIdx.x * 512 + tid; i < nch; i += G * 512) { const f32x4 a = *(const GAS f32x4*)(pl + (size_t)i * 8), b = *(const GAS f32x4*)(pl + (size_t)i * 8 + 4);
            v4u o; o.x = pk2(a.x, a.y); o.y = pk2(a.z, a.w); o.z = pk2(b.x, b.y); o.w = pk2(b.z, b.w); *(GAS v4u*)(pb + (size_t)i * 8) = o; }
    }
    if (l == 0) {
        bf16* xb = (bf16*)(ws + WS_XB0); float* ssa = (float*)(ws + WS_SSA);
        for (int m = gw; m < M; m += NGW) {
            const GAS f32x4* xr = (const GAS f32x4*)(A->in[I_X] + (size_t)m * DM) + lane; GAS f32x4* orow = (GAS f32x4*)(A->out + (size_t)m * DM) + lane;
            GAS unsigned long long* o8 = (GAS unsigned long long*)(xb + (size_t)m * DM) + lane;
            float s = 0.f;
#pragma unroll
            for (int j = 0; j < 4; ++j) { const f32x4 v = xr[64 * j]; s += (v.x * v.x + v.y * v.y) + (v.z * v.z + v.w * v.w); orow[64 * j] = v;
                o8[64 * j] = (unsigned long long)pk2(v.x, v.y) | ((unsigned long long)pk2(v.z, v.w) << 32); }
            s = wave_sum(s);
            if (lane < 16) ssa[(size_t)m * 16 + lane] = (lane == 0) ? s : 0.f;
        }
        if (blockIdx.x == 0) { float* bt = (float*)(ws + WS_BT);
            for (int i = tid; i < 8 * 128; i += 512) { const int hq = i >> 7, dist = i & 127; bt[i] = A->in[I_REL_BIAS][(int)T5_BUCKET[dist] * 8 + hq]; } }
    }
}

__device__ __forceinline__ void mlstm_local_unit(LAS unsigned char* lds, const int tid, int uid, const bf16* Z, const float* IFb, float* Cst, float* Nst, float* GM) {
    const int lane = tid & 63, wave = tid >> 6;
    const int h = uid & 3; const size_t row0 = (size_t)(uid >> 2) * 64;
    LAS float* kw = (LAS float*)lds;
    LAS float* vv = kw + 64 * 64;
    LAS float* wv = vv + 64 * 128;
    if (wave == 0) {
        const float ip = IFb[(row0 + lane) * 8 + h], fp = IFb[(row0 + lane) * 8 + 4 + h];
        const float lf = logsigmoidf_(fp);
        const float bc = wave_incl_sum(lf, lane);
        const float g = __shfl(bc, 63);
        const float a = g - bc + ip;
        const float ml = wave_max(a);
        wv[lane] = expf(a - ml);
        if (lane == 0) { GM[uid * 4 + 0] = g; GM[uid * 4 + 1] = ml; }
    }
    __syncthreads();
    {
        const int t = tid >> 3, ch = tid & 7; const bf16* zr = Z + (row0 + t) * NIN; const float w = wv[t] * 0.125f;
        float f[8];
        unpack8(*(const u32x4*)(zr + ZC_MK + h * 64 + ch * 8), f);
#pragma unroll
        for (int e = 0; e < 8; ++e) kw[t * 64 + ch * 8 + e] = w * f[e];
        unpack8(*(const u32x4*)(zr + ZC_MV + h * 128 + ch * 8), f);
#pragma unroll
        for (int e = 0; e < 8; ++e) vv[t * 128 + ch * 8 + e] = f[e];
        unpack8(*(const u32x4*)(zr + ZC_MV + h * 128 + 64 + ch * 8), f);
#pragma unroll
        for (int e = 0; e < 8; ++e) vv[t * 128 + 64 + ch * 8 + e] = f[e];
    }
    __syncthreads();
    {
        const int e = tid & 127, dg = tid >> 7; float acc[16];
#pragma unroll
        for (int j = 0; j < 16; ++j) acc[j] = 0.f;
#pragma unroll 4
        for (int t = 0; t < 64; ++t) { const float xv = vv[t * 128 + e]; const LAS f32x4* kp = (const LAS f32x4*)(kw + t * 64 + dg * 16);
#pragma unroll
            for (int j4 = 0; j4 < 4; ++j4) { const f32x4 k4 = kp[j4]; acc[j4 * 4 + 0] += k4.x * xv; acc[j4 * 4 + 1] += k4.y * xv; acc[j4 * 4 + 2] += k4.z * xv; acc[j4 * 4 + 3] += k4.w * xv; } }
        float* cp = Cst + (size_t)uid * 8192 + (size_t)(dg * 16) * 128 + e;
#pragma unroll
        for (int j = 0; j < 16; ++j) cp[j * 128] = acc[j];
    }
    if (tid < 64) { float s = 0.f;
#pragma unroll 8
        for (int t = 0; t < 64; ++t) s += kw[t * 64 + tid];
        Nst[(size_t)uid * 64 + tid] = s; }
    __syncthreads();
}

__device__ __forceinline__ void mlstm_scan(const int tid, float* Cst, float* Nst, float* GM, int G) {
    const int nthr = G * 512;
    for (int e = blockIdx.x * 512 + tid; e < 32 * 8192; e += nthr) {
        const int bh = e >> 13, idx = e & 8191, b = bh >> 2, h = bh & 3;
        float C = 0.f, n = 0.f, m = 0.f; const bool do_n = idx < 64, wr_m = idx == 0;
        for (int c0 = 0; c0 < 64; c0 += 8) {
            float cv[8], gg[8], mm[8], nv[8];
#pragma unroll
            for (int j = 0; j < 8; ++j) { const size_t uid = (size_t)((b * 64 + c0 + j) * 4 + h); cv[j] = Cst[uid * 8192 + idx]; gg[j] = GM[uid * 4]; mm[j] = GM[uid * 4 + 1]; nv[j] = do_n ? Nst[uid * 64 + idx] : 0.f; }
#pragma unroll
            for (int j = 0; j < 8; ++j) { const size_t uid = (size_t)((b * 64 + c0 + j) * 4 + h);
                const float mn = fmaxf(gg[j] + m, mm[j]); const float so = expf(gg[j] + m - mn), sn = expf(mm[j] - mn);
                Cst[uid * 8192 + idx] = C; if (do_n) Nst[uid * 64 + idx] = n; if (wr_m) GM[uid * 4 + 2] = m;
                C = so * C + sn * cv[j]; n = so * n + sn * nv[j]; m = mn; }
        }
    }
}

__device__ __forceinline__ void mlstm_out_unit(LAS unsigned char* lds, const int tid, int uid, const bf16* Z, const float* IFb, const float* Cst, const float* Nst, const float* GM, const float* gain, bf16* HA) {
    const int lane = tid & 63, wave = tid >> 6;
    const int h = uid & 3; const size_t row0 = (size_t)(uid >> 2) * 64;
    LAS float* qs = (LAS float*)lds;
    LAS float* ks = qs + 64 * 65;
    LAS float* Ws = ks + 64 * 65;
    LAS float* vs = Ws + 64 * 65;
    LAS float* Cs = vs + 64 * 128;
    LAS float* bs = Cs + 64 * 128; LAS float* iv = bs + 64; LAS float* mt = iv + 64; LAS float* si = mt + 64; LAS float* ns = si + 64;
    if (wave == 0) {
        const float ip = IFb[(row0 + lane) * 8 + h], fp = IFb[(row0 + lane) * 8 + 4 + h];
        const float lf = logsigmoidf_(fp);
        const float bc = wave_incl_sum(lf, lane);
        const float pmx = wave_incl_max(ip - bc, lane);
        const float mprev = GM[uid * 4 + 2];
        const float ee = bc + mprev;
        const float mtv = fmaxf(bc + pmx, ee);
        bs[lane] = bc; iv[lane] = ip; mt[lane] = mtv; si[lane] = expf(ee - mtv); ns[lane] = Nst[(size_t)uid * 64 + lane];
    }
    {
        const int t = tid >> 3, ch = tid & 7; const bf16* zr = Z + (row0 + t) * NIN;
        float f[8];
        unpack8(*(const u32x4*)(zr + ZC_MQ + h * 64 + ch * 8), f);
#pragma unroll
        for (int e = 0; e < 8; ++e) qs[t * 65 + ch * 8 + e] = f[e];
        unpack8(*(const u32x4*)(zr + ZC_MK + h * 64 + ch * 8), f);
#pragma unroll
        for (int e = 0; e < 8; ++e) ks[t * 65 + ch * 8 + e] = f[e] * 0.125f;
        unpack8(*(const u32x4*)(zr + ZC_MV + h * 128 + ch * 8), f);
#pragma unroll
        for (int e = 0; e < 8; ++e) vs[t * 128 + ch * 8 + e] = f[e];
        unpack8(*(const u32x4*)(zr + ZC_MV + h * 128 + 64 + ch * 8), f);
#pragma unroll
        for (int e = 0; e < 8; ++e) vs[t * 128 + 64 + ch * 8 + e] = f[e];
        const f32x4* cg = (const f32x4*)(Cst + (size_t)uid * 8192);
#pragma unroll
        for (int i = 0; i < 4; ++i) *(LAS f32x4*)(Cs + (size_t)(tid + 512 * i) * 4) = cg[tid + 512 * i];
    }
    __syncthreads();
    {
        const int t = tid >> 3, sg = tid & 7; float sc[8];
#pragma unroll
        for (int j = 0; j < 8; ++j) sc[j] = 0.f;
#pragma unroll 4
        for (int d = 0; d < 64; ++d) { const float qd = qs[t * 65 + d];
#pragma unroll
            for (int j = 0; j < 8; ++j) sc[j] += qd * ks[(sg * 8 + j) * 65 + d]; }
        const float bt_ = bs[t], mtt = mt[t];
#pragma unroll
        for (int j = 0; j < 8; ++j) { const int s = sg * 8 + j; const float w = (s <= t) ? expf(bt_ - bs[s] + iv[s] - mtt) * sc[j] : 0.f; Ws[t * 65 + s] = w; }
    }
    __syncthreads();
    {
        const int t = tid >> 3, eg = tid & 7; float a1[16], a2[16];
#pragma unroll
        for (int j = 0; j < 16; ++j) { a1[j] = 0.f; a2[j] = 0.f; }
#pragma unroll 2
        for (int s = 0; s < 64; ++s) { const float w = Ws[t * 65 + s]; const LAS f32x4* vp = (const LAS f32x4*)(vs + s * 128 + eg * 16);
#pragma unroll
            for (int j4 = 0; j4 < 4; ++j4) { const f32x4 v4 = vp[j4]; a1[j4 * 4 + 0] += w * v4.x; a1[j4 * 4 + 1] += w * v4.y; a1[j4 * 4 + 2] += w * v4.z; a1[j4 * 4 + 3] += w * v4.w; } }
#pragma unroll 2
        for (int d = 0; d < 64; ++d) { const float qd = qs[t * 65 + d]; const LAS f32x4* cp = (const LAS f32x4*)(Cs + d * 128 + eg * 16);
#pragma unroll
            for (int j4 = 0; j4 < 4; ++j4) { const f32x4 c4 = cp[j4]; a2[j4 * 4 + 0] += qd * c4.x; a2[j4 * 4 + 1] += qd * c4.y; a2[j4 * 4 + 2] += qd * c4.z; a2[j4 * 4 + 3] += qd * c4.w; } }
        const float sint = si[t];
        float dp = 0.f, qn = 0.f;
#pragma unroll
        for (int j = 0; j < 8; ++j) { dp += Ws[t * 65 + eg * 8 + j]; qn += qs[t * 65 + eg * 8 + j] * ns[eg * 8 + j]; }
        dp += __shfl_xor(dp, 1); dp += __shfl_xor(dp, 2); dp += __shfl_xor(dp, 4);
        qn += __shfl_xor(qn, 1); qn += __shfl_xor(qn, 2); qn += __shfl_xor(qn, 4);
        const float den = dp + sint * qn; const float denom = fmaxf(fabsf(den), expf(-mt[t])); const float inv = 1.0f / denom;
        float hv[16]; float ssq = 0.f;
#pragma unroll
        for (int j = 0; j < 16; ++j) { hv[j] = (a1[j] + sint * a2[j]) * inv; ssq += hv[j] * hv[j]; }
        ssq += __shfl_xor(ssq, 1); ssq += __shfl_xor(ssq, 2); ssq += __shfl_xor(ssq, 4);
        const float rn = 1.0f / sqrtf(ssq * (1.0f / 128.0f) + EPSF);
        const bf16* zr = Z + (row0 + t) * NIN + ZC_MO + h * 128 + eg * 16; const float* gp = gain + h * 128 + eg * 16;
        float og[8], o[8];
        unpack8(*(const u32x4*)zr, og);
#pragma unroll
        for (int j = 0; j < 8; ++j) o[j] = hv[j] * rn * gp[j] * og[j];
        bf16* hp = HA + (row0 + t) * 512 + h * 128 + eg * 16;
        *(u32x4*)hp = pack8f(o);
        unpack8(*(const u32x4*)(zr + 8), og);
#pragma unroll
        for (int j = 0; j < 8; ++j) o[j] = hv[8 + j] * rn * gp[8 + j] * og[j];
        *(u32x4*)(hp + 8) = pack8f(o);
    }
    __syncthreads();
}

__device__ __forceinline__ void swa_unit(LAS unsigned char* lds, const int tid, int uid, const bf16* Z, const float* qg, const float* kg, const float* sinks, const float* bt, bf16* HB) {
    const int kvh = uid & 1, nb = (uid >> 1) & 31, b = uid >> 6;
    LAS unsigned char* Ks = lds; LAS unsigned char* Vs = lds + 256 * 144; LAS float* bl = (LAS float*)(lds + 2 * 256 * 144);
#pragma unroll
    for (int i = 0; i < 4; ++i) { const int c = tid + 512 * i, j = c >> 3, ch = c & 7; const bool ok = (nb > 0) || (j >= 128);
        const size_t krow = (size_t)b * SEQ + (size_t)(nb * 128 + j) - 128;
        u32x4 kq = (u32x4){0u, 0u, 0u, 0u}, vq = (u32x4){0u, 0u, 0u, 0u};
        if (ok) { kq = *(const u32x4*)(Z + krow * NIN + ZC_SK + kvh * 64 + ch * 8); vq = *(const u32x4*)(Z + krow * NIN + ZC_SV + kvh * 64 + ch * 8); }
        float kf[8]; unpack8(kq, kf); float ssq = 0.f;
#pragma unroll
        for (int e = 0; e < 8; ++e) ssq += kf[e] * kf[e];
        ssq += __shfl_xor(ssq, 1); ssq += __shfl_xor(ssq, 2); ssq += __shfl_xor(ssq, 4);
        const float rn = 1.0f / sqrtf(ssq * (1.0f / 64.0f) + EPSF);
#pragma unroll
        for (int e = 0; e < 8; ++e) kf[e] = kf[e] * rn * kg[ch * 8 + e];
        *(LAS u32x4*)(Ks + j * 144 + ch * 16) = pack8f(kf); *(LAS u32x4*)(Vs + j * 144 + ch * 16) = vq; }
    const int qi = tid & 127, g = tid >> 7, hq = kvh * 4 + g;
    bl[tid] = bt[hq * 128 + qi];
    const size_t row = (size_t)b * SEQ + nb * 128 + qi;
    float q[64];
    {
        const bf16* qp = Z + row * NIN + ZC_SQ + hq * 64; float ssq = 0.f;
#pragma unroll
        for (int c = 0; c < 8; ++c) { float f[8]; unpack8(*(const u32x4*)(qp + c * 8), f);
#pragma unroll
            for (int e = 0; e < 8; ++e) { q[c * 8 + e] = f[e]; ssq += f[e] * f[e]; } }
        const float rn = 0.125f / sqrtf(ssq * (1.0f / 64.0f) + EPSF);
#pragma unroll
        for (int d = 0; d < 64; ++d) q[d] = q[d] * rn * qg[d];
    }
    __syncthreads();
    float o[64];
#pragma unroll
    for (int d = 0; d < 64; ++d) o[d] = 0.f;
    float mx = sinks[hq], l = 1.f;
    const LAS float* blg = bl + g * 128;
    for (int j = 0; j < 128; ++j) {
        const int kk = qi + 1 + j;
        if ((nb > 0) || (kk >= 128)) {
            const LAS u32x4* kr = (const LAS u32x4*)(Ks + kk * 144);
            float s0 = 0.f, s1 = 0.f;
#pragma unroll
            for (int c = 0; c < 8; ++c) { const u32x4 w = kr[c];
                s0 += q[c * 8 + 0] * bflo(w.x); s1 += q[c * 8 + 1] * bfhi(w.x); s0 += q[c * 8 + 2] * bflo(w.y); s1 += q[c * 8 + 3] * bfhi(w.y);
                s0 += q[c * 8 + 4] * bflo(w.z); s1 += q[c * 8 + 5] * bfhi(w.z); s0 += q[c * 8 + 6] * bflo(w.w); s1 += q[c * 8 + 7] * bfhi(w.w); }
            const float s = s0 + s1 + blg[127 - j];
            const float mn = fmaxf(mx, s); const float corr = __expf(mx - mn), pp = __expf(s - mn);
            l = l * corr + pp; mx = mn;
            const LAS u32x4* vr = (const LAS u32x4*)(Vs + kk * 144);
#pragma unroll
            for (int c = 0; c < 8; ++c) { const u32x4 w = vr[c];
                o[c * 8 + 0] = o[c * 8 + 0] * corr + pp * bflo(w.x); o[c * 8 + 1] = o[c * 8 + 1] * corr + pp * bfhi(w.x); o[c * 8 + 2] = o[c * 8 + 2] * corr + pp * bflo(w.y); o[c * 8 + 3] = o[c * 8 + 3] * corr + pp * bfhi(w.y);
                o[c * 8 + 4] = o[c * 8 + 4] * corr + pp * bflo(w.z); o[c * 8 + 5] = o[c * 8 + 5] * corr + pp * bfhi(w.z); o[c * 8 + 6] = o[c * 8 + 6] * corr + pp * bflo(w.w); o[c * 8 + 7] = o[c * 8 + 7] * corr + pp * bfhi(w.w); }
        }
    }
    {
        const float il = 1.0f / l; bf16* hp = HB + row * 512 + hq * 64;
#pragma unroll
        for (int c = 0; c < 8; ++c) { float f[8];
#pragma unroll
            for (int e = 0; e < 8; ++e) f[e] = o[c * 8 + e] * il;
            *(u32x4*)(hp + c * 8) = pack8f(f); }
    }
    __syncthreads();
}

#ifndef PH_MASK
#define PH_MASK 0xFFF
#endif
#define HAS(k) (((PH_MASK) >> (k)) & 1)
__global__ void __launch_bounds__(NWAVES * 64, 2) fwd_kernel(Args args_unused) {
    extern __shared__ __attribute__((aligned(16))) unsigned char lds_raw[];
    LAS unsigned char* lds = (LAS unsigned char*)lds_raw;
    const KArgs ka = (KArgs)__builtin_amdgcn_kernarg_segment_ptr();
    const int G = gridDim.x, bx = (int)blockIdx.x;
    for (int u = threadIdx.x; u < (LDS_BYTES - LDSCTL_OFF) / 4; u += NWAVES * 64) ((LAS unsigned*)(lds + LDSCTL_OFF))[u] = 0u;
    __syncthreads();
    volatile LAS unsigned* MISC = (volatile LAS unsigned*)(lds + MISC_OFF);
    const int lo = ka->ph_lo, hi = ka->ph_hi;
    XcdBarrier bar; bar.bar = (unsigned*)((gu32*)(ka->ws + WS_CTL) + CW_BAR) + ka->li * XCD_BAR_WORDS; bar.x = 0; bar.st = nullptr;
    if (hi - lo > 1) bar = xcd_barrier_post(bar.bar, MISC + 8);
#define IN(k) (lo <= (k) && (k) < hi)
#define SEAM(k) do { if (IN((k) + 1)) xcd_barrier(bar); } while (0)
#define WSP(T, off) ((T*)(ws + (off)))

    for (int l = 0; l < DEPTH; ++l) {
        const int pb = 12 * l;
        if (HAS(0) && IN(pb + 0)) { phase_convert(ka, l, lds, G); SEAM(pb + 0); }
        if (HAS(1) && IN(pb + 1)) {
            PHASE_ENTRY(ka);
            pg8::Gemm g{WSP(bf16, WS_XB0), WSP(bf16, WS_W) + WO_UP1, M, NUP, DM}; pg8::StaticOrder S; S.init(M, NUP, G, bx);
            pg8::EpiUp E{WSP(bf16, WS_H), FF, WSP(float, WS_SSA)};
            pg8::gemm_phase<pg8::EpiUp, pg8::StaticOrder, true, true>(lds + RING_OFF, g, S, E);
            SEAM(pb + 1);
        }
        if (HAS(2) && IN(pb + 2)) {
            PHASE_ENTRY(ka);
            pg8::Gemm g{WSP(bf16, WS_H), WSP(bf16, WS_W) + WO_DN1, M, DM, FF}; pg8::StaticOrder S; S.init(M, DM, G, bx);
            pg8::EpiRes<0> E{A->out, WSP(bf16, WS_XB0), WSP(float, WS_SSB), 0.5f, nullptr, nullptr};
            pg8::gemm_phase<pg8::EpiRes<0>, pg8::StaticOrder, true, true>(lds + RING_OFF, g, S, E);
            SEAM(pb + 2);
        }
        if (HAS(3) && IN(pb + 3)) {
            PHASE_ENTRY(ka);
            pg8::Gemm g{WSP(bf16, WS_XB0), WSP(bf16, WS_W) + WO_IN, M, NIN, DM}; pg8::StaticOrder S; S.init(M, NIN, G, bx);
            pg8::EpiIn E{WSP(bf16, WS_Z), NIN, WSP(float, WS_SSB), WSP(float, WS_IF), A->in[I_B_I] + l * 4, A->in[I_B_F] + l * 4};
            pg8::gemm_phase<pg8::EpiIn, pg8::StaticOrder, true, true>(lds + RING_OFF, g, S, E);
            SEAM(pb + 3);
        }
        if (HAS(4) && IN(pb + 4)) {
            { PHASE_ENTRY(ka);
              for (int u = bx; u < NUNIT_ML; u += G) mlstm_local_unit(lds, tid, u, WSP(bf16, WS_Z), WSP(float, WS_IF), WSP(float, WS_CST), WSP(float, WS_NST), WSP(float, WS_GM)); }
            { PHASE_ENTRY(ka);
              for (int u = bx; u < NUNIT_SW; u += G) swa_unit(lds, tid, u, WSP(bf16, WS_Z), A->in[I_Q_NORM] + l * 64, A->in[I_K_NORM] + l * 64, A->in[I_SINKS] + l * 8, WSP(float, WS_BT), WSP(bf16, WS_HB)); }
            SEAM(pb + 4);
        }
        if (HAS(5) && IN(pb + 5)) { PHASE_ENTRY(ka); mlstm_scan(tid, WSP(float, WS_CST), WSP(float, WS_NST), WSP(float, WS_GM), G); SEAM(pb + 5); }
        if (HAS(6) && IN(pb + 6)) {
            PHASE_ENTRY(ka);
            for (int u = bx; u < NUNIT_ML; u += G) mlstm_out_unit(lds, tid, u, WSP(bf16, WS_Z), WSP(float, WS_IF), WSP(float, WS_CST), WSP(float, WS_NST), WSP(float, WS_GM), A->in[I_ML_NORM] + l * 512, WSP(bf16, WS_HA));
            SEAM(pb + 6);
        }
        if (HAS(7) && IN(pb + 7)) {
            { PHASE_ENTRY(ka);
              pg8::Gemm g{WSP(bf16, WS_HA), WSP(bf16, WS_W) + WO_A, M, DM, 512}; pg8::StaticOrder S; S.init(M, DM, G, bx);
              pg8::EpiMix<0> E{WSP(bf16, WS_MIX), WSP(bf16, WS_Z), NIN, ZC_GA};
              pg8::gemm_phase<pg8::EpiMix<0>, pg8::StaticOrder, true, true>(lds + RING_OFF, g, S, E); }
            { PHASE_ENTRY(ka);
              pg8::Gemm g{WSP(bf16, WS_HB), WSP(bf16, WS_W) + WO_B, M, DM, 512}; pg8::StaticOrder S; S.init(M, DM, G, bx);
              pg8::EpiMix<1> E{WSP(bf16, WS_MIX), WSP(bf16, WS_Z), NIN, ZC_GB};
              pg8::gemm_phase<pg8::EpiMix<1>, pg8::StaticOrder, true, true>(lds + RING_OFF, g, S, E); }
            SEAM(pb + 7);
        }
        if (HAS(8) && IN(pb + 8)) {
            PHASE_ENTRY(ka);
            pg8::Gemm g{WSP(bf16, WS_MIX), WSP(bf16, WS_W) + WO_OUT, M, DM, DM}; pg8::StaticOrder S; S.init(M, DM, G, bx);
            pg8::EpiRes<0> E{A->out, WSP(bf16, WS_XB0), WSP(float, WS_SSA), 1.0f, nullptr, nullptr};
            pg8::gemm_phase<pg8::EpiRes<0>, pg8::StaticOrder, true, true>(lds + RING_OFF, g, S, E);
            SEAM(pb + 8);
        }
        if (HAS(9) && IN(pb + 9)) {
            PHASE_ENTRY(ka);
            pg8::Gemm g{WSP(bf16, WS_XB0), WSP(bf16, WS_W) + WO_UP2, M, NUP, DM}; pg8::StaticOrder S; S.init(M, NUP, G, bx);
            pg8::EpiUp E{WSP(bf16, WS_H), FF, WSP(float, WS_SSA)};
            pg8::gemm_phase<pg8::EpiUp, pg8::StaticOrder, true, true>(lds + RING_OFF, g, S, E);
            SEAM(pb + 9);
        }
        if (HAS(10) && IN(pb + 10)) {
            PHASE_ENTRY(ka);
            pg8::Gemm g{WSP(bf16, WS_H), WSP(bf16, WS_W) + WO_DN2, M, DM, FF}; pg8::StaticOrder S; S.init(M, DM, G, bx);
            pg8::EpiRes<0> E{A->out, WSP(bf16, WS_XB1), WSP(float, WS_SSB), 0.5f, nullptr, nullptr};
            pg8::gemm_phase<pg8::EpiRes<0>, pg8::StaticOrder, true, true>(lds + RING_OFF, g, S, E);
            SEAM(pb + 10);
        }
        if (HAS(11) && IN(pb + 11)) {
            { PHASE_ENTRY(ka);
              int kpe = PD; asm volatile("" : "+s"(kpe));
              pg8::Gemm g{WSP(bf16, WS_PB), WSP(bf16, WS_W) + WO_PLE, M, DM, kpe}; pg8::StaticOrder S; S.init(M, DM, G, bx);
              pg8::EpiPlain E{WSP(bf16, WS_PE), DM};
              pg8::gemm_phase<pg8::EpiPlain, pg8::StaticOrder, true, true>(lds + RING_OFF, g, S, E); }
            { PHASE_ENTRY(ka);
              pg8::Gemm g{WSP(bf16, WS_XB1), WSP(bf16, WS_W) + WO_PG, M, DM, DM}; pg8::StaticOrder S; S.init(M, DM, G, bx);
              pg8::EpiRes<1> E{A->out, WSP(bf16, WS_XB0), WSP(float, WS_SSA), 1.0f, WSP(float, WS_SSB), WSP(bf16, WS_PE)};
              pg8::gemm_phase<pg8::EpiRes<1>, pg8::StaticOrder, true, true>(lds + RING_OFF, g, S, E); }
            SEAM(pb + 11);
        }
    }
#undef IN
#undef SEAM
}

extern "C" void kernel_launch(void* const* d_in, const int* in_sizes, int n_in, void* d_out, int out_size, void* d_ws, size_t ws_size, hipStream_t stream) {
    static int grid = 0;
    if (grid == 0) {
        if (n_in != 23 || in_sizes[0] != M * DM || out_size != M * DM || ws_size < WS_END) { fprintf(stderr, "kernel_launch: unexpected shapes: n_in %d in0 %d out %d ws %zu (need %zu)\n", n_in, n_in > 0 ? in_sizes[0] : -1, out_size, ws_size, (size_t)WS_END); grid = -1; return; }
        int dev = 0, cus = 0, per_cu = 0;
        if (hipGetDevice(&dev) != hipSuccess || hipDeviceGetAttribute(&cus, hipDeviceAttributeMultiprocessorCount, dev) != hipSuccess) { fprintf(stderr, "kernel_launch: device query failed\n"); grid = -1; return; }
        if (hipFuncSetAttribute((const void*)fwd_kernel, hipFuncAttributeMaxDynamicSharedMemorySize, LDS_BYTES) != hipSuccess) { fprintf(stderr, "kernel_launch: hipFuncSetAttribute failed\n"); grid = -1; return; }
        if (hipOccupancyMaxActiveBlocksPerMultiprocessor(&per_cu, (const void*)fwd_kernel, NWAVES * 64, LDS_BYTES) != hipSuccess || per_cu < 1) fprintf(stderr, "kernel_launch: occupancy query reports %d blocks per CU\n", per_cu);
        (void)hipGetLastError();
        grid = cus < 256 ? cus : 256;
        if (grid != 256) fprintf(stderr, "kernel_launch: %d CUs; this kernel is laid out for 256\n", cus);
    }
    if (grid < 0) return;
    if (hipMemsetAsync((char*)d_ws + WS_CTL, 0, CTL_ZERO_BYTES, stream) != hipSuccess) { fprintf(stderr, "kernel_launch: memset failed\n"); return; }
    Args a{};
    for (int i = 0; i < 23; ++i) a.in[i] = (const float*)d_in[i];
    a.out = (float*)d_out; a.ws = (unsigned char*)d_ws; a.pad = 0;
    constexpr int NL = MK_N_LAUNCHES;
    for (int li = 0; li < NL; ++li) {
        a.ph_lo = (int)((long)NPHASE * li / NL); a.ph_hi = (int)((long)NPHASE * (li + 1) / NL); a.li = li;
        hipLaunchKernelGGL(fwd_kernel, dim3(grid), dim3(NWAVES * 64), LDS_BYTES, stream, a);
        const hipError_t le = hipPeekAtLastError();
        if (le != hipSuccess) { fprintf(stderr, "kernel_launch: launch %d failed: %s\n", li, hipGetErrorName(le)); break; }
    }
}
```

```cpp
#define MK_N_LAUNCHES 1
#include <hip/hip_runtime.h>
#include <cstdio>
#include <cstdint>
#include <cmath>
namespace pg8 {
#define PG8_LAS __attribute__((address_space(3)))
typedef unsigned short bf16_t;
typedef short bf16x8 __attribute__((ext_vector_type(8)));
typedef float f32x4 __attribute__((ext_vector_type(4)));
typedef unsigned u32x4 __attribute__((ext_vector_type(4)));
constexpr int BM = 256, BK = 64, HALF = 128, HTB = HALF * BK * 2  , STAGE_BYTES = 8 * HTB, NXCD = 8, WGM = 8;

__host__ __device__ __forceinline__ int lds_byte(int r, int c) { const int st = (r >> 4) * 2 + (c >> 5), rr = r & 15, cc = c & 31, ob = rr * 64 + cc * 2; return st * 1024 + (ob ^ (((ob >> 9) & 1) << 5)); }
__host__ __device__ __forceinline__ void stage_rc(int b, int& R, int& C) { const int st = b / 1024, sb = b % 1024, swz = sb ^ (((sb >> 9) & 1) << 5); R = (st >> 1) * 16 + swz / 64; C = (st & 1) * 32 + (swz % 64) / 2; }
__host__ __device__ __forceinline__ int perm32(int rho) { const int n = rho >> 4, i = rho & 15; return 8 * (i >> 2) + 4 * n + (i & 3); }

struct Unit { int pm, pn; };
struct Gemm { const bf16_t* A; const bf16_t* Bt; int M, N, K; };

struct StaticOrder {
    int nM, nN, nwg, G, c, r0 = 0, r1 = 1 << 30;
    __host__ __device__ void init(int M, int N, int G_, int c_) { nM = M / BM; nN = N / BM; nwg = nM * nN; G = G_; c = c_; }
    __host__ __device__ bool next(int i, Unit& u) const {
        i += r0; if (i >= r1) return false;
        const long L = (long)i * G + c; if (L >= nwg) return false;
        int wgid = (int)L; { const int q = nwg / NXCD, r = nwg % NXCD, xcd = wgid % NXCD, off = wgid / NXCD; wgid = (xcd < r ? xcd * (q + 1) : r * (q + 1) + (xcd - r) * q) + off; }
        const int nig = WGM * nN, gid = wgid / nig, fm = gid * WGM, gsz = (nM - fm) < WGM ? (nM - fm) : WGM;
        u.pm = fm + ((wgid % nig) % gsz); u.pn = (wgid % nig) / gsz; return true;
    }
    __device__ __forceinline__ void a_ready(const Unit&) const {}
    __device__ __forceinline__ void done(const Unit&) const {}
};

typedef float f32x2 __attribute__((ext_vector_type(2)));
__device__ __forceinline__ unsigned cvt_pk_bf16(float lo, float hi) { unsigned r; asm volatile("v_cvt_pk_bf16_f32 %0, %1, %2" : "=v"(r) : "v"(lo), "v"(hi)); return r; }
__device__ __forceinline__ float bf_lo(unsigned w) { return __uint_as_float(w << 16); }
__device__ __forceinline__ float bf_hi(unsigned w) { return __uint_as_float(w & 0xffff0000u); }
__device__ __forceinline__ float sigmoidf_(float v) { return __builtin_amdgcn_rcpf(1.0f + __expf(-v)); }
__device__ __forceinline__ u32x4 pack8(const f32x4 a, const f32x4 b) { u32x4 w; w.x = cvt_pk_bf16(a[0], a[1]); w.y = cvt_pk_bf16(a[2], a[3]); w.z = cvt_pk_bf16(b[0], b[1]); w.w = cvt_pk_bf16(b[2], b[3]); return w; }
constexpr int SSW = 16;
constexpr float RMS_EPS = 1e-6f;
__device__ __forceinline__ void row_rs8(const float* ss, int row0, int fq, float (&rr)[8]) {
    f32x4 sv[8];
#pragma unroll
    for (int it = 0; it < 8; ++it) sv[it] = *(const f32x4*)(ss + (size_t)(row0 + (it >> 2) * HALF + (it & 3) * 16) * SSW + fq * 4);
#pragma unroll
    for (int it = 0; it < 8; ++it) { float s = (sv[it][0] + sv[it][1]) + (sv[it][2] + sv[it][3]); s += __shfl_xor(s, 16); s += __shfl_xor(s, 32); rr[it] = __builtin_amdgcn_rsqf(s * (1.0f / 1024.0f) + RMS_EPS); }
}

struct RowTab { const PG8_LAS float* tab; int pm_hi; const float* ss; };
__device__ __forceinline__ void row_rs8_tab(const RowTab& T, const Unit& u, int wr, int fr, int fq, float (&rr)[8]) {
    if ((u.pm | 8) == T.pm_hi) { const PG8_LAS float* t = T.tab + ((u.pm >> 3) & 1) * 256 + wr * 64 + fr;
#pragma unroll
        for (int it = 0; it < 8; ++it) rr[it] = t[(it >> 2) * HALF + (it & 3) * 16];
    } else row_rs8(T.ss, u.pm * BM + wr * 64 + fr, fq, rr);
}

struct EpiUp {
    static constexpr bool PERM = true, AFTER_DRAIN = false;
    bf16_t* H; int ldh; RowTab rt;
    __device__ __forceinline__ void operator()(const f32x4 (&acc)[2][2][4][2], const Unit& u, int wr, int wc, int fr_in, int fq_in) const {
        int fr = fr_in, fq = fq_in; asm volatile("" : "+v"(fr), "+v"(fq));
        const int row0 = u.pm * BM + wr * 64 + fr, hcol = u.pn * HALF + wc * 32 + 8 * fq;
        float rr[8]; row_rs8_tab(rt, u, wr, fr, fq, rr);
#pragma unroll
        for (int ai = 0; ai < 2; ++ai)
#pragma unroll
            for (int m = 0; m < 4; ++m) { int row = row0 + ai * HALF + m * 16; asm volatile("" : "+v"(row)); const float r = rr[ai * 4 + m];
                const float nrl = -1.4426950408889634f * r, r2 = r * r;
                f32x2 o[4];
#pragma unroll
                for (int n = 0; n < 2; ++n)
#pragma unroll
                    for (int hh = 0; hh < 2; ++hh) { const f32x2 g = (f32x2){acc[ai][0][m][n][2 * hh], acc[ai][0][m][n][2 * hh + 1]}, uu = (f32x2){acc[ai][1][m][n][2 * hh], acc[ai][1][m][n][2 * hh + 1]};
                        const f32x2 t = g * nrl; f32x2 d; d.x = __builtin_amdgcn_exp2f(t.x); d.y = __builtin_amdgcn_exp2f(t.y); d = d + 1.0f;
                        f32x2 iv; iv.x = __builtin_amdgcn_rcpf(d.x); iv.y = __builtin_amdgcn_rcpf(d.y);
                        o[n * 2 + hh] = (g * uu) * (iv * r2); }
                u32x4 w; w.x = cvt_pk_bf16(o[0].x, o[0].y); w.y = cvt_pk_bf16(o[1].x, o[1].y); w.z = cvt_pk_bf16(o[2].x, o[2].y); w.w = cvt_pk_bf16(o[3].x, o[3].y);
                *(u32x4*)(H + (size_t)row * ldh + hcol) = w; }
    }
};
template <int MODE> struct EpiRes {
    static constexpr bool PERM = true, AFTER_DRAIN = false;
    static constexpr int PF = (MODE == 1) ? 3 : 8;
    const bf16_t* XR; bf16_t* XW; float* ssw; float scale; const float* ssr; const bf16_t* PE; float* OUT;
    __device__ __forceinline__ void operator()(const f32x4 (&acc)[2][2][4][2], const Unit& u, int wr, int wc, int fr_in, int fq_in) const {
        int fr = fr_in, fq = fq_in; asm volatile("" : "+v"(fr), "+v"(fq));
        const int row0 = u.pm * BM + wr * 64 + fr, col0 = u.pn * BM + wc * 32 + 8 * fq;
        u32x4 xv[PF][2], pv[PF][2]; f32x4 sv[PF];
#define ER_LOAD(it, slot) do { int row_ = row0 + ((it) >> 2) * HALF + ((it) & 3) * 16; asm volatile("" : "+v"(row_)); \
            _Pragma("unroll") for (int bj = 0; bj < 2; ++bj) { const size_t off_ = (size_t)row_ * 1024 + col0 + bj * HALF; \
                xv[slot][bj] = *(const u32x4*)(XR + off_); if (MODE == 1) pv[slot][bj] = *(const u32x4*)(PE + off_); } \
            if (MODE == 1) sv[slot] = *(const f32x4*)(ssr + (size_t)row_ * SSW + fq * 4); } while (0)
#pragma unroll
        for (int it = 0; it < PF; ++it) ER_LOAD(it, it);
        asm volatile("" ::: "memory");
#pragma unroll
        for (int it = 0; it < 8; ++it) { const int ai = it >> 2, m = it & 3, slot = it % PF;
            int row = row0 + ai * HALF + m * 16; asm volatile("" : "+v"(row));
            float r = 0.f;
            if (MODE == 1) { const f32x4 v = sv[slot]; float s = (v[0] + v[1]) + (v[2] + v[3]); s += __shfl_xor(s, 16); s += __shfl_xor(s, 32); r = 1.0f / sqrtf(s * (1.0f / 1024.0f) + RMS_EPS); }
            float q = 0.f;
#pragma unroll
            for (int bj = 0; bj < 2; ++bj) { const size_t off = (size_t)row * 1024 + col0 + bj * HALF;
                const u32x4 xw = xv[slot][bj];
                f32x4 x0 = (f32x4){bf_lo(xw.x), bf_hi(xw.x), bf_lo(xw.y), bf_hi(xw.y)}, x1 = (f32x4){bf_lo(xw.z), bf_hi(xw.z), bf_lo(xw.w), bf_hi(xw.w)};
                f32x4 a0 = acc[ai][bj][m][0], a1 = acc[ai][bj][m][1];
                if (MODE == 1) { const u32x4 pw = pv[slot][bj];
                    a0[0] = sigmoidf_(a0[0] * r) * bf_lo(pw.x); a0[1] = sigmoidf_(a0[1] * r) * bf_hi(pw.x); a0[2] = sigmoidf_(a0[2] * r) * bf_lo(pw.y); a0[3] = sigmoidf_(a0[3] * r) * bf_hi(pw.y);
                    a1[0] = sigmoidf_(a1[0] * r) * bf_lo(pw.z); a1[1] = sigmoidf_(a1[1] * r) * bf_hi(pw.z); a1[2] = sigmoidf_(a1[2] * r) * bf_lo(pw.w); a1[3] = sigmoidf_(a1[3] * r) * bf_hi(pw.w);
                } else { a0 = a0 * scale; a1 = a1 * scale; }
                x0 = x0 + a0; x1 = x1 + a1;
                if (OUT) { *(f32x4*)(OUT + off) = x0; *(f32x4*)(OUT + off + 4) = x1; }
                q += (x0[0] * x0[0] + x0[1] * x0[1]) + (x0[2] * x0[2] + x0[3] * x0[3]) + (x1[0] * x1[0] + x1[1] * x1[1]) + (x1[2] * x1[2] + x1[3] * x1[3]);
                if (!OUT) *(u32x4*)(XW + off) = pack8(x0, x1); }
            q += __shfl_xor(q, 16); q += __shfl_xor(q, 32);
            if (!OUT && fq == 0) ssw[(size_t)row * SSW + u.pn * 4 + wc] = q;
            if (it + PF < 8) ER_LOAD(it + PF, slot);
            asm volatile("" ::: "memory"); }
#undef ER_LOAD
    }
};
struct EpiIn {
    static constexpr bool PERM = true, AFTER_DRAIN = false;
    bf16_t* Z; int ldz; RowTab rt; float* IF; const float* bi; const float* bf;
    __device__ __forceinline__ void operator()(const f32x4 (&acc)[2][2][4][2], const Unit& u, int wr, int wc, int fr_in, int fq_in) const {
        int fr = fr_in, fq = fq_in; asm volatile("" : "+v"(fr), "+v"(fq));
        const int row0 = u.pm * BM + wr * 64 + fr, col0 = u.pn * BM + wc * 32 + 8 * fq; const int pn = u.pn;
        float rr[8]; row_rs8_tab(rt, u, wr, fr, fq, rr);
        if (pn == 17) {
            const f32x4 bi4 = *(const f32x4*)bi, bf4 = *(const f32x4*)bf;
#pragma unroll
            for (int ai = 0; ai < 2; ++ai)
#pragma unroll
                for (int m = 0; m < 4; ++m) { int row = row0 + ai * HALF + m * 16; asm volatile("" : "+v"(row)); const float r = rr[ai * 4 + m];
                    if (wc == 0 && fq == 0) { *(f32x4*)(IF + (size_t)row * 8) = acc[ai][0][m][0] * r + bi4; *(f32x4*)(IF + (size_t)row * 8 + 4) = acc[ai][0][m][1] * r + bf4; } }
            return;
        }
        if (pn >= 9) {
            const int gc = (pn - 9) * HALF + wc * 32 + 8 * fq;
#pragma unroll
            for (int ai = 0; ai < 2; ++ai)
#pragma unroll
                for (int m = 0; m < 4; ++m) { int row = row0 + ai * HALF + m * 16; asm volatile("" : "+v"(row)); const float nrl = -1.4426950408889634f * rr[ai * 4 + m];
                    f32x4 rq[2], gq[2];
#pragma unroll
                    for (int n = 0; n < 2; ++n)
#pragma unroll
                        for (int hh = 0; hh < 2; ++hh) { f32x2 ta = (f32x2){acc[ai][0][m][n][2 * hh], acc[ai][0][m][n][2 * hh + 1]} * nrl, tb = (f32x2){acc[ai][1][m][n][2 * hh], acc[ai][1][m][n][2 * hh + 1]} * nrl;
                            ta = __builtin_elementwise_min(ta, (f32x2){60.f, 60.f}); tb = __builtin_elementwise_min(tb, (f32x2){60.f, 60.f});
                            f32x2 da, db; da.x = __builtin_amdgcn_exp2f(ta.x); da.y = __builtin_amdgcn_exp2f(ta.y); db.x = __builtin_amdgcn_exp2f(tb.x); db.y = __builtin_amdgcn_exp2f(tb.y); da = da + 1.0f; db = db + 1.0f;
                            f32x2 ia, ib; ia.x = __builtin_amdgcn_rcpf(da.x); ia.y = __builtin_amdgcn_rcpf(da.y); ib.x = __builtin_amdgcn_rcpf(db.x); ib.y = __builtin_amdgcn_rcpf(db.y);
                            const f32x2 rv = db * ia; rq[n][2 * hh] = rv.x; rq[n][2 * hh + 1] = rv.y; gq[n][2 * hh] = ib.x; gq[n][2 * hh + 1] = ib.y; }
                    *(u32x4*)(Z + (size_t)row * ldz + 2304 + gc) = pack8(rq[0], rq[1]); *(u32x4*)(Z + (size_t)row * ldz + 3328 + gc) = pack8(gq[0], gq[1]); }
            return;
        }
        const bool sig = (pn == 4) || (pn == 5);
#pragma unroll
        for (int ai = 0; ai < 2; ++ai)
#pragma unroll
            for (int m = 0; m < 4; ++m) { int row = row0 + ai * HALF + m * 16; asm volatile("" : "+v"(row)); const float r = rr[ai * 4 + m];
#pragma unroll
                for (int bj = 0; bj < 2; ++bj) { f32x4 v0, v1;
                    if (sig) { const float nrl = -1.4426950408889634f * r;
#pragma unroll
                        for (int hh = 0; hh < 2; ++hh) { f32x2 t0 = (f32x2){acc[ai][bj][m][0][2 * hh], acc[ai][bj][m][0][2 * hh + 1]} * nrl, t1 = (f32x2){acc[ai][bj][m][1][2 * hh], acc[ai][bj][m][1][2 * hh + 1]} * nrl;
                            f32x2 d0, d1; d0.x = __builtin_amdgcn_exp2f(t0.x); d0.y = __builtin_amdgcn_exp2f(t0.y); d1.x = __builtin_amdgcn_exp2f(t1.x); d1.y = __builtin_amdgcn_exp2f(t1.y); d0 = d0 + 1.0f; d1 = d1 + 1.0f;
                            v0[2 * hh] = __builtin_amdgcn_rcpf(d0.x); v0[2 * hh + 1] = __builtin_amdgcn_rcpf(d0.y); v1[2 * hh] = __builtin_amdgcn_rcpf(d1.x); v1[2 * hh + 1] = __builtin_amdgcn_rcpf(d1.y); }
                    } else { v0 = acc[ai][bj][m][0] * r; v1 = acc[ai][bj][m][1] * r; }
                    *(u32x4*)(Z + (size_t)row * ldz + col0 + bj * HALF) = pack8(v0, v1); } }
    }
};
struct EpiMixH {
    static constexpr bool PERM = true, AFTER_DRAIN = false;
    bf16_t* MIX; const bf16_t* Z; int ldz;
    template <int GOFF> __device__ __forceinline__ void scale(f32x4 (&acc)[2][2][4][2], const Unit& u, int wr, int wc, int fr_in, int fq_in, bool store) const {
        int fr = fr_in, fq = fq_in; asm volatile("" : "+v"(fr), "+v"(fq));
        const int row0 = u.pm * BM + wr * 64 + fr, col0 = u.pn * BM + wc * 32 + 8 * fq;
        u32x4 gv[8][2];
#pragma unroll
        for (int it = 0; it < 8; ++it) { int row_ = row0 + (it >> 2) * HALF + (it & 3) * 16; asm volatile("" : "+v"(row_));
#pragma unroll
            for (int bj = 0; bj < 2; ++bj) gv[it][bj] = *(const u32x4*)(Z + (size_t)row_ * ldz + GOFF + col0 + bj * HALF); }
#pragma unroll
        for (int it = 0; it < 8; ++it) { const int ai = it >> 2, m = it & 3; int row = row0 + ai * HALF + m * 16; asm volatile("" : "+v"(row));
#pragma unroll
            for (int bj = 0; bj < 2; ++bj) { const u32x4 gw = gv[it][bj];
                f32x4 v0 = acc[ai][bj][m][0], v1 = acc[ai][bj][m][1];
                v0[0] *= bf_lo(gw.x); v0[1] *= bf_hi(gw.x); v0[2] *= bf_lo(gw.y); v0[3] *= bf_hi(gw.y);
                v1[0] *= bf_lo(gw.z); v1[1] *= bf_hi(gw.z); v1[2] *= bf_lo(gw.w); v1[3] *= bf_hi(gw.w);
                if (store) *(u32x4*)(MIX + (size_t)row * 1024 + col0 + bj * HALF) = pack8(v0, v1);
                else { acc[ai][bj][m][0] = v0; acc[ai][bj][m][1] = v1; } } }
    }
    __device__ __forceinline__ void mid(f32x4 (&acc)[2][2][4][2], const Unit& u, int wr, int wc, int fr, int fq) const { scale<2304>(acc, u, wr, wc, fr, fq, false); }
    __device__ __forceinline__ void operator()(const f32x4 (&acc)[2][2][4][2], const Unit& u, int wr, int wc, int fr, int fq) const {
        scale<3328>(const_cast<f32x4 (&)[2][2][4][2]>(acc), u, wr, wc, fr, fq, true); }
};
struct EpiPlain {
    static constexpr bool PERM = true, AFTER_DRAIN = false;
    bf16_t* O; int ldc;
    __device__ __forceinline__ void operator()(const f32x4 (&acc)[2][2][4][2], const Unit& u, int wr, int wc, int fr_in, int fq_in) const {
        int fr = fr_in, fq = fq_in; asm volatile("" : "+v"(fr), "+v"(fq));
        const int row0 = u.pm * BM + wr * 64 + fr, col0 = u.pn * BM + wc * 32 + 8 * fq;
#pragma unroll
        for (int ai = 0; ai < 2; ++ai)
#pragma unroll
            for (int m = 0; m < 4; ++m) { int row = row0 + ai * HALF + m * 16; asm volatile("" : "+v"(row));
#pragma unroll
                for (int bj = 0; bj < 2; ++bj) *(u32x4*)(O + (size_t)row * ldc + col0 + bj * HALF) = pack8(acc[ai][bj][m][0], acc[ai][bj][m][1]); }
    }
};

template <class Epi, class Sched, bool ALIGN_EPI = false, bool SP2 = false, bool MIDHOOK = false>
__device__ __forceinline__ void gemm_phase(PG8_LAS unsigned char* lds, const Gemm g, const Sched& S, const Epi& E) {
    int tid_l = threadIdx.x; asm volatile("" : "+v"(tid_l));
    const int tid = tid_l, wid = __builtin_amdgcn_readfirstlane(tid >> 6), lane = tid & 63, wr = wid >> 2, wc = wid & 3, fr = lane & 15, fq = lane >> 4;
    const int K = g.K, nt = K / BK;
    unsigned voffA[2], voffB[2];
#pragma unroll
    for (int i = 0; i < 2; ++i) { int R, C; stage_rc(tid * 16 + i * 8192, R, C); const int Rb = Epi::PERM ? ((R & ~31) + perm32(R & 31)) : R;
        voffA[i] = (unsigned)(R * K + C) * 2u; voffB[i] = (unsigned)(Rb * K + C) * 2u; }
    const size_t kstep = (size_t)(BK * 2);
    const size_t hstep = (size_t)HALF * K * 2;
    const size_t tstep = 2 * hstep;
    const unsigned ldsw = (unsigned)wid * 1024u;
    const int aoff = lds_byte(wr * 64 + fr, fq * 8), boff = lds_byte(wc * 32 + fr, fq * 8);
#define PG8_SA(b, h) (((b) * 2 + (h)) * HTB)
#define PG8_SB(b, h) ((4 + (b) * 2 + (h)) * HTB)
#define PG8_STAGE(bufoff, gbase, voff) do { _Pragma("unroll") for (int _i = 0; _i < 2; ++_i) \
        __builtin_amdgcn_global_load_lds((const unsigned*)((const char*)(gbase) + (voff)[_i]), (PG8_LAS unsigned*)(lds + (bufoff) + ldsw + _i * 8192), 16, 0, 0); } while (0)
#define PG8_LDA(dst, b, h) do { _Pragma("unroll") for (int m = 0; m < 4; ++m) _Pragma("unroll") for (int k = 0; k < 2; ++k) dst[m][k] = *(const PG8_LAS bf16x8*)(lds + PG8_SA(b, h) + aoff + m * 2048 + k * 1024); } while (0)
#define PG8_LDB(dst, b, h) do { _Pragma("unroll") for (int n = 0; n < 2; ++n) _Pragma("unroll") for (int k = 0; k < 2; ++k) dst[n][k] = *(const PG8_LAS bf16x8*)(lds + PG8_SB(b, h) + boff + n * 2048 + k * 1024); } while (0)
#define PG8_MMA(ai, bj, At, Bt) do { __builtin_amdgcn_s_setprio(1); _Pragma("unroll") for (int m = 0; m < 4; ++m) _Pragma("unroll") for (int n = 0; n < 2; ++n) _Pragma("unroll") for (int k = 0; k < 2; ++k) \
        acc[ai][bj][m][n] = __builtin_amdgcn_mfma_f32_16x16x32_bf16(Bt[n][k], At[m][k], acc[ai][bj][m][n], 0, 0, 0); __builtin_amdgcn_s_setprio(0); } while (0)
#define PG8_WAIT_V(n) asm volatile("s_waitcnt vmcnt(" #n ")" ::: "memory")
#define PG8_WAIT_L(n) asm volatile("s_waitcnt lgkmcnt(" #n ")" ::: "memory")
#define PG8_BAR __builtin_amdgcn_s_barrier()
#define PG8_SCHED __builtin_amdgcn_sched_barrier(0)
    Unit cur, nxt; int ui = 0;
    if (!S.next(0, cur)) return;
    f32x4 acc[2][2][4][2];
#pragma unroll
    for (int a = 0; a < 2; ++a)
#pragma unroll
        for (int b = 0; b < 2; ++b)
#pragma unroll
            for (int m = 0; m < 4; ++m)
#pragma unroll
                for (int n = 0; n < 2; ++n) acc[a][b][m][n] = (f32x4){0.f, 0.f, 0.f, 0.f};
    bf16x8 At[4][2], B0[2][2], B1[2][2];
    const char* cA = (const char*)g.A + (size_t)cur.pm * tstep; const char* cB = (const char*)g.Bt + (size_t)cur.pn * tstep;
    S.a_ready(cur);
    if constexpr (SP2) {
        PG8_STAGE(PG8_SB(0, 0), cB, voffB); PG8_STAGE(PG8_SB(0, 1), cB + hstep, voffB); PG8_STAGE(PG8_SA(0, 0), cA, voffA); PG8_STAGE(PG8_SA(0, 1), cA + hstep, voffA);
        if (wr == 1) PG8_BAR;
        PG8_WAIT_V(2); PG8_BAR;
        PG8_STAGE(PG8_SB(1, 0), cB + kstep, voffB); PG8_STAGE(PG8_SA(1, 0), cA + kstep, voffA); PG8_STAGE(PG8_SB(1, 1), cB + hstep + kstep, voffB);
        PG8_WAIT_V(6); PG8_BAR;
    } else {
        PG8_STAGE(PG8_SB(0, 0), cB, voffB); PG8_STAGE(PG8_SA(0, 0), cA, voffA); PG8_STAGE(PG8_SB(0, 1), cB + hstep, voffB); PG8_STAGE(PG8_SA(0, 1), cA + hstep, voffA);
        if (wr == 1) PG8_BAR;
        PG8_WAIT_V(4); PG8_BAR;
        PG8_STAGE(PG8_SB(1, 0), cB + kstep, voffB); PG8_STAGE(PG8_SA(1, 0), cA + kstep, voffA); PG8_STAGE(PG8_SB(1, 1), cB + hstep + kstep, voffB);
        PG8_WAIT_V(6); PG8_BAR;
    }
    for (;;) {
        const bool has_next = S.next(ui + 1, nxt);
        const char* nA = has_next ? (const char*)g.A + (size_t)nxt.pm * tstep : cA; const char* nB = has_next ? (const char*)g.Bt + (size_t)nxt.pn * tstep : cB;
        for (int t = 0; t < nt; t += 2) {
            if constexpr (MIDHOOK) { if (t == (nt >> 1)) E.mid(acc, cur, wr, wc, fr, fq); }
            const bool last = (t == nt - 2);
            const char* a1 = cA + (size_t)(t + 1) * kstep;
            const char* a2 = last ? nA : cA + (size_t)(t + 2) * kstep; const char* b2 = last ? nB : cB + (size_t)(t + 2) * kstep;
            const char* a3 = a2 + kstep; const char* b3 = b2 + kstep;
            if (last && has_next) S.a_ready(nxt);
            if constexpr (SP2) {
            PG8_LDB(B0, 0, 0); PG8_LDB(B1, 0, 1); PG8_SCHED; PG8_LDA(At, 0, 0); PG8_STAGE(PG8_SA(1, 1), a1 + hstep, voffA);
            PG8_WAIT_V(8); PG8_WAIT_L(0); PG8_BAR; PG8_MMA(0, 0, At, B0); PG8_MMA(0, 1, At, B1); PG8_BAR; PG8_SCHED;
            PG8_LDA(At, 0, 1); PG8_STAGE(PG8_SB(0, 0), b2, voffB); PG8_STAGE(PG8_SB(0, 1), b2 + hstep, voffB); PG8_STAGE(PG8_SA(0, 0), a2, voffA);
            PG8_WAIT_V(8); PG8_WAIT_L(0); PG8_BAR; PG8_MMA(1, 0, At, B0); PG8_MMA(1, 1, At, B1); PG8_BAR; PG8_SCHED;
            PG8_LDB(B0, 1, 0); PG8_LDB(B1, 1, 1); PG8_SCHED; PG8_LDA(At, 1, 0); PG8_STAGE(PG8_SA(0, 1), a2 + hstep, voffA);
            PG8_WAIT_V(8); PG8_WAIT_L(0); PG8_BAR; PG8_MMA(0, 0, At, B0); PG8_MMA(0, 1, At, B1); PG8_BAR; PG8_SCHED;
            PG8_LDA(At, 1, 1); PG8_STAGE(PG8_SB(1, 0), b3, voffB); PG8_STAGE(PG8_SB(1, 1), b3 + hstep, voffB); PG8_STAGE(PG8_SA(1, 0), a3, voffA);
            PG8_WAIT_V(8); PG8_WAIT_L(0); PG8_BAR; PG8_MMA(1, 0, At, B0); PG8_MMA(1, 1, At, B1); PG8_BAR; PG8_SCHED;
            } else {
            PG8_LDB(B0, 0, 0); PG8_SCHED; PG8_LDA(At, 0, 0); PG8_STAGE(PG8_SA(1, 1), a1 + hstep, voffA);
            PG8_WAIT_L(8); PG8_BAR; PG8_WAIT_L(0); PG8_MMA(0, 0, At, B0); PG8_BAR; PG8_SCHED;
            PG8_LDB(B1, 0, 1); PG8_STAGE(PG8_SB(0, 0), b2, voffB);
            PG8_BAR; PG8_WAIT_L(0); PG8_MMA(0, 1, At, B1); PG8_BAR;
            PG8_LDA(At, 0, 1); PG8_STAGE(PG8_SA(0, 0), a2, voffA);
            PG8_BAR; PG8_WAIT_L(0); PG8_MMA(1, 0, At, B0); PG8_BAR; PG8_SCHED;
            PG8_STAGE(PG8_SB(0, 1), b2 + hstep, voffB);
            PG8_WAIT_V(6); PG8_BAR; PG8_MMA(1, 1, At, B1); PG8_BAR;
            PG8_LDB(B0, 1, 0); PG8_SCHED; PG8_LDA(At, 1, 0); PG8_STAGE(PG8_SA(0, 1), a2 + hstep, voffA);
            PG8_WAIT_L(8); PG8_BAR; PG8_WAIT_L(0); PG8_MMA(0, 0, At, B0); PG8_BAR; PG8_SCHED;
            PG8_LDB(B1, 1, 1); PG8_STAGE(PG8_SB(1, 0), b3, voffB);
            PG8_BAR; PG8_WAIT_L(0); PG8_MMA(0, 1, At, B1); PG8_BAR;
            PG8_LDA(At, 1, 1); PG8_STAGE(PG8_SA(1, 0), a3, voffA);
            PG8_BAR; PG8_WAIT_L(0); PG8_MMA(1, 0, At, B0); PG8_BAR; PG8_SCHED;
            PG8_STAGE(PG8_SB(1, 1), b3 + hstep, voffB);
            PG8_WAIT_V(6); PG8_BAR; PG8_MMA(1, 1, At, B1); PG8_BAR;
            }
        }
        if constexpr (ALIGN_EPI) { if (wr == 0) PG8_BAR; }
        if constexpr (!Epi::AFTER_DRAIN) { E(acc, cur, wr, wc, fr, fq); S.done(cur); }
        if (!has_next) break;
#pragma unroll
        for (int a = 0; a < 2; ++a)
#pragma unroll
            for (int b = 0; b < 2; ++b)
#pragma unroll
                for (int m = 0; m < 4; ++m)
#pragma unroll
                    for (int n = 0; n < 2; ++n) acc[a][b][m][n] = (f32x4){0.f, 0.f, 0.f, 0.f};
        cur = nxt; cA = nA; cB = nB; ++ui;
        if constexpr (ALIGN_EPI) { if (wr == 1) PG8_BAR; }
    }
    PG8_WAIT_V(0);
    if constexpr (!ALIGN_EPI) { if (wr == 0) PG8_BAR; }
    PG8_BAR;
    if constexpr (Epi::AFTER_DRAIN) { E.fused(acc, cur, wr, wc, fr, fq, lds, wid, lane); S.done(cur); }
#undef PG8_SA
#undef PG8_SB
#undef PG8_STAGE
#undef PG8_LDA
#undef PG8_LDB
#undef PG8_MMA
#undef PG8_WAIT_V
#undef PG8_WAIT_L
#undef PG8_BAR
#undef PG8_SCHED
}
}
#define GAS __attribute__((address_space(1)))
#define LAS __attribute__((address_space(3)))
typedef unsigned short bf16;
typedef unsigned v4u __attribute__((ext_vector_type(4)));
typedef float f32x4 __attribute__((ext_vector_type(4)));
typedef short bf16x8 __attribute__((ext_vector_type(8)));
typedef GAS unsigned gu32;
typedef GAS unsigned long long gu64;
#define RLX_AGENT __ATOMIC_RELAXED, __HIP_MEMORY_SCOPE_AGENT
#define LDS_WAIT() asm volatile("s_waitcnt lgkmcnt(0)" ::: "memory")
#define VM_WAIT() asm volatile("s_waitcnt vmcnt(0)" ::: "memory")
__device__ __forceinline__ unsigned long long rt() { return __builtin_amdgcn_s_memrealtime(); }
__device__ __forceinline__ unsigned f2bf(float f) { unsigned u = __builtin_bit_cast(unsigned, f); return (u + 0x7fffu + ((u >> 16) & 1u)) >> 16; }
__device__ __forceinline__ unsigned pk2(float lo, float hi) { return f2bf(lo) | (f2bf(hi) << 16); }

#define XB_TMO      128
#define XB_XCNT(j)  (256  + 64 * (j))
#define XB_XSUB(j)  (1280 + 64 * (j))
#define XB_XGEN(j)  (2304 + 64 * (j))
#define XB_TOP      3328
#define XB_TOPGEN   3392
#define XCD_BAR_WORDS 3456
#define XB_SPIN_CAP (1u << 18)

__device__ __forceinline__ unsigned xb_ld(unsigned* p)              { return __hip_atomic_load(p, __ATOMIC_RELAXED, __HIP_MEMORY_SCOPE_AGENT); }
__device__ __forceinline__ unsigned xb_add(unsigned* p, unsigned v) { return __hip_atomic_fetch_add(p, v, __ATOMIC_RELAXED, __HIP_MEMORY_SCOPE_AGENT); }
__device__ __forceinline__ unsigned xb_xcc_id() { return (unsigned)__builtin_amdgcn_s_getreg((3 << 11) | 20) & 0xFu; }
#define XB_SPIN(cond, bar) do { unsigned _sp = 0; while (cond) { __builtin_amdgcn_s_sleep(1); \
    if ((++_sp & 255u) == 0u) { if (xb_ld(&(bar)[XB_TMO])) break; if (_sp > XB_SPIN_CAP) { atomicAdd(&(bar)[XB_TMO], 1u); break; } } } } while (0)

struct XcdBarrier {
    unsigned* bar; unsigned x;
    volatile LAS unsigned* st;
};

__device__ __forceinline__ XcdBarrier xcd_barrier_post(unsigned* bar, volatile LAS unsigned* st) {
    XcdBarrier b; b.bar = bar; b.x = xb_xcc_id(); b.st = st;
    if (threadIdx.x == 0) (void)xb_add(&bar[XB_XCNT(b.x)], 1u);
    return b;
}
__device__ __forceinline__ void xcd_barrier_complete(unsigned* bar, unsigned x, unsigned& nloc, unsigned& nx) {
    const unsigned G = gridDim.x * gridDim.y * gridDim.z;
    unsigned sum, cnt, mine, sp = 0u;
    for (;;) {
        sum = 0u; cnt = 0u; mine = 0u;
#pragma unroll
        for (unsigned j = 0; j < 16; ++j) { const unsigned c = xb_ld(&bar[XB_XCNT(j)]); sum += c; cnt += (c > 0u) ? 1u : 0u; mine = (j == x) ? c : mine; }
        if (sum == G) break;
        __builtin_amdgcn_s_sleep(1);
        if ((++sp & 255u) == 0u) { if (xb_ld(&bar[XB_TMO])) break; if (sp > XB_SPIN_CAP) { atomicAdd(&bar[XB_TMO], 1u); break; } }
    }
    nloc = mine > 0u ? mine : 1u; nx = cnt > 0u ? cnt : 1u;
}

__device__ __forceinline__ void xcd_barrier(const XcdBarrier& b) {
    asm volatile("s_waitcnt vmcnt(0)" ::: "memory");
    __syncthreads();
    if (threadIdx.x == 0) {
        unsigned* bar = b.bar;
        __builtin_amdgcn_s_waitcnt(0);
        unsigned nloc = b.st[0], nx = b.st[1];
        if (nloc == 0u) { unsigned xo = b.x; asm volatile("" : "+s"(xo)); xcd_barrier_complete(bar, xo, nloc, nx); b.st[0] = nloc; b.st[1] = nx; }
        const unsigned old = xb_add(&bar[XB_XSUB(b.x)], 1u);
        const unsigned gen = old / nloc;
        if (old + 1u == (gen + 1u) * nloc) {
            __builtin_amdgcn_fence(__ATOMIC_RELEASE, "agent");
            asm volatile("s_waitcnt vmcnt(0)" ::: "memory");
            const unsigned og = xb_add(&bar[XB_TOP], 1u);
            const unsigned tg = og / nx;
            if (og + 1u == (tg + 1u) * nx) xb_add(&bar[XB_TOPGEN], 1u);
            else XB_SPIN(xb_ld(&bar[XB_TOPGEN]) == tg, bar);
            __builtin_amdgcn_fence(__ATOMIC_ACQUIRE, "agent");
            xb_add(&bar[XB_XGEN(b.x)], 1u);
            asm volatile("s_waitcnt vmcnt(0)" ::: "memory");
        } else {
            XB_SPIN(xb_ld(&bar[XB_XGEN(b.x)]) == gen, bar);
            __builtin_amdgcn_fence(__ATOMIC_ACQUIRE, "agent");
            asm volatile("s_waitcnt vmcnt(0)" ::: "memory");
        }
    }
    __syncthreads();
}

constexpr int NWAVES = 8;
constexpr int NBATCH = 8, SEQ = 4096, DM = 1024, DEPTH = 4, M = NBATCH * SEQ, PD = 256, FF = 2816, NUP = 2 * FF, DIN = 4360, NIN = 4608;
constexpr int NUNIT_ML = NBATCH * 64 * 4;
constexpr int NUNIT_SW = NBATCH * 32 * 2;
constexpr float EPSF = 1e-6f;
constexpr int ZC_MQ = 0, ZC_MK = 256, ZC_MV = 512, ZC_MO = 1024, ZC_SQ = 1536, ZC_SK = 2048, ZC_SV = 2176, ZC_GA = 2304, ZC_GB = 3328, ZC_IF = 4352;

constexpr size_t MiB = 1u << 20;
constexpr size_t WS_CTL = 0, CTL_REGION_BYTES = 1 * MiB;
constexpr size_t WS_SSA = 1 * MiB, WS_SSB = 3 * MiB;
constexpr size_t WS_IF = 5 * MiB;
constexpr size_t WS_NST = 6 * MiB;
constexpr size_t WS_GM = 6 * MiB + 512 * 1024;
constexpr size_t WS_NP = 6 * MiB + 576 * 1024;
constexpr size_t WS_CPT = 202 * MiB;
constexpr size_t WS_BT = 7 * MiB + 512 * 1024;
constexpr size_t WS_W = 8 * MiB;
constexpr size_t WS_PB = 58 * MiB;
constexpr size_t WS_XB0 = 74 * MiB;
constexpr size_t WS_HA = 138 * MiB;
constexpr size_t WS_PE = 138 * MiB;
constexpr size_t WS_MIX = 202 * MiB;
constexpr size_t WS_CST = 266 * MiB;
constexpr size_t WS_Z = 330 * MiB;
constexpr size_t WS_H = WS_Z;
constexpr size_t WS_XB1 = WS_Z + 192 * MiB;
constexpr size_t WS_END = 618 * MiB;
constexpr size_t WO_UP1 = 0, WO_DN1 = WO_UP1 + (size_t)NUP * DM, WO_IN = WO_DN1 + (size_t)DM * FF, WO_A = WO_IN + (size_t)NIN * DM, WO_B = WO_A + (size_t)DM * 512,
                 WO_OUT = WO_B + (size_t)DM * 512, WO_UP2 = WO_OUT + (size_t)DM * DM, WO_DN2 = WO_UP2 + (size_t)NUP * DM, WO_PG = WO_DN2 + (size_t)DM * FF, WO_PLE = WO_PG + (size_t)DM * DM,
                 WO_END = WO_PLE + (size_t)DM * PD;
static_assert(WO_END * 2 <= 50 * MiB, "weights fit");
static_assert(WS_Z + (size_t)M * NIN * 2 <= WS_END && WS_H + (size_t)M * FF * 2 <= WS_XB1 && WS_XB1 + (size_t)M * DM * 2 <= WS_END, "ws map");
constexpr int CW_BAR = 4096;
constexpr int NPHASE = 12 * DEPTH;
#ifndef MK_N_LAUNCHES
#define MK_N_LAUNCHES 1
#endif
constexpr size_t CTL_ZERO_BYTES = (((size_t)(CW_BAR + (MK_N_LAUNCHES) * XCD_BAR_WORDS) * 4 + 4095) / 4096) * 4096;
static_assert(CTL_ZERO_BYTES <= CTL_REGION_BYTES, "barrier words inside the control region");

constexpr int RING_OFF = 0, RING_BYTES = 131072;
constexpr int LDSCTL_OFF = RING_BYTES, MISC_OFF = LDSCTL_OFF + 320;
constexpr int LDS_BYTES = 147456;
constexpr int RTAB_OFF = LDSCTL_OFF + 1024;

typedef unsigned u32x4 __attribute__((ext_vector_type(4)));
typedef short bf16x8_t __attribute__((ext_vector_type(8)));
typedef unsigned u32x2 __attribute__((ext_vector_type(2)));
__device__ const unsigned char T5_BUCKET[128] = {0,1,2,3,4,5,6,7,8,9,10,11,12,13,14,15,16,16,16,17,17,18,18,18,19,19,19,20,20,20,20,21,21,21,21,22,22,22,22,22,23,23,23,23,23,23,24,24,24,24,24,24,25,25,25,25,25,25,25,26,26,26,26,26,26,26,26,27,27,27,27,27,27,27,27,27,27,28,28,28,28,28,28,28,28,28,28,29,29,29,29,29,29,29,29,29,29,29,29,30,30,30,30,30,30,30,30,30,30,30,30,30,30,31,31,31,31,31,31,31,31,31,31,31,31,31,31,31};

__device__ __forceinline__ float bflo(unsigned w) { return __uint_as_float(w << 16); }
__device__ __forceinline__ float bfhi(unsigned w) { return __uint_as_float(w & 0xffff0000u); }
__device__ __forceinline__ void unpack8(const u32x4 w, float (&f)[8]) { f[0] = bflo(w.x); f[1] = bfhi(w.x); f[2] = bflo(w.y); f[3] = bfhi(w.y); f[4] = bflo(w.z); f[5] = bfhi(w.z); f[6] = bflo(w.w); f[7] = bfhi(w.w); }
__device__ __forceinline__ u32x4 pack8f(const float (&f)[8]) { u32x4 w; w.x = pk2(f[0], f[1]); w.y = pk2(f[2], f[3]); w.z = pk2(f[4], f[5]); w.w = pk2(f[6], f[7]); return w; }
__device__ __forceinline__ float wave_sum(float v) {
#pragma unroll
    for (int o = 1; o < 64; o <<= 1) v += __shfl_xor(v, o);
    return v;
}
__device__ __forceinline__ float wave_max(float v) {
#pragma unroll
    for (int o = 1; o < 64; o <<= 1) v = fmaxf(v, __shfl_xor(v, o));
    return v;
}
__device__ __forceinline__ float wave_incl_sum(float v, int lane) {
#pragma unroll
    for (int o = 1; o < 64; o <<= 1) { const float t = __shfl_up(v, o); if (lane >= o) v += t; }
    return v;
}
__device__ __forceinline__ float wave_incl_max(float v, int lane) {
#pragma unroll
    for (int o = 1; o < 64; o <<= 1) { const float t = __shfl_up(v, o); if (lane >= o) v = fmaxf(v, t); }
    return v;
}
__device__ __forceinline__ float logsigmoidf_(float x) { return fminf(x, 0.f) - log1pf(expf(-fabsf(x))); }

template <int MAP> __device__ __forceinline__ int cvt_map(int n, int N) {
    if (n >= N) return -1;
    if (MAP == 1) { return n < FF ? ((n >> 7) * 256 + (n & 127)) : (((n - FF) >> 7) * 256 + 128 + ((n - FF) & 127)); }
    if (MAP == 2) { if (n < 1536) return n; if (n < 1544) return ZC_IF + n - 1536; if (n < 2312) return n - 8;
        if (n < 3336) { const int j = n - 2312; return ZC_GA + (j >> 7) * 256 + (j & 127); }
        const int j = n - 3336; return ZC_GA + (j >> 7) * 256 + 128 + (j & 127); }
    return n;
}
template <int MAP> __device__ __forceinline__ void cvt_item(const float* W, int K, int N, const float* gain, bf16* WT, LAS float* scr, int item, int lane, int ldw = 0, int koff = 0) {
    if (ldw == 0) ldw = K;
    const int nblk = (N + 31) / 32, kb = item / nblk, nb = item % nblk, k0 = 64 * kb, n0 = 32 * nb;
    const int nn = n0 + (lane & 31); const bool nv = nn < N;
    float wreg[32];
#pragma unroll
    for (int i = 0; i < 32; ++i) { const int kk = 2 * i + (lane >> 5); wreg[i] = nv ? W[(size_t)(k0 + kk) * N + nn] : 0.f; }
#pragma unroll
    for (int i = 0; i < 32; ++i) { const int kk = 2 * i + (lane >> 5); float w = wreg[i]; if (gain) w *= gain[k0 + kk]; scr[kk * 33 + (lane & 31)] = w; }
    LDS_WAIT(); asm volatile("" ::: "memory");
    const int c = lane & 7;
#pragma unroll
    for (int j = 0; j < 4; ++j) { const int n = (lane >> 3) + 8 * j; const LAS float* s = scr + (8 * c) * 33 + n;
        v4u o; o.x = pk2(s[0 * 33], s[1 * 33]); o.y = pk2(s[2 * 33], s[3 * 33]); o.z = pk2(s[4 * 33], s[5 * 33]); o.w = pk2(s[6 * 33], s[7 * 33]);
        const int dr = cvt_map<MAP>(n0 + n, N);
        if (dr >= 0) *(GAS v4u*)(WT + (size_t)dr * ldw + koff + k0 + 8 * c) = o; }
    LDS_WAIT(); asm volatile("" ::: "memory");
}

struct Args { const float* in[23]; float* out; unsigned char* ws; int ph_lo, ph_hi, li, pad; };
typedef const __attribute__((address_space(4))) Args* KArgs;
enum { I_X = 0, I_P, I_FFN1_NORM, I_FFN1_WI, I_FFN1_WO, I_MIX_NORM, I_W_IN, I_B_I, I_B_F, I_ML_NORM, I_Q_NORM, I_K_NORM, I_SINKS, I_REL_BIAS, I_W_A, I_W_B, I_W_OUT, I_FFN2_NORM, I_FFN2_WI, I_FFN2_WO, I_PLE_NORM, I_W_PG, I_W_PLE };
#define PHASE_ENTRY(ka) KArgs A = (ka); asm volatile("" : "+s"(A)); int tid = threadIdx.x; asm volatile("" : "+v"(tid)); unsigned char* const ws = A->ws; (void)ws; (void)tid

__device__ __forceinline__ void convert_part(KArgs ka, LAS unsigned char* lds, int lb, int la, int brank, int nblocks, int w0, int w1) {
    PHASE_ENTRY(ka);
    const int lane = tid & 63, wave = tid >> 6;
    LAS float* scr = (LAS float*)(lds + wave * 16384);
    bf16* Wb = (bf16*)(ws + WS_W);
    constexpr int I_UP = (DM / 64) * (NUP / 32), I_DN = (FF / 64) * (DM / 32), I_IN = (DM / 64) * ((DIN + 31) / 32), I_A = (512 / 64) * (DM / 32), I_OUT = (DM / 64) * (DM / 32), I_PLE = (PD / 64) * (DM / 32);
    constexpr int NB_ITEMS = I_UP + I_DN + 2 * I_A + 2 * I_OUT + I_PLE, NA_ITEMS = I_UP + I_DN + I_IN;
    const int nB = (lb >= 0) ? NB_ITEMS : 0, nA = (la >= 0) ? NA_ITEMS : 0, NI = nB + nA;
    const int i0 = (int)((long)NI * w0 / 256), i1 = (int)((long)NI * w1 / 256);
    for (int it = i0 + brank * NWAVES + wave; it < i1; it += nblocks * NWAVES) {
        int r = it;
        if (r < nB) { const int l = lb;
            if (r < I_UP) { cvt_item<1>(A->in[I_FFN2_WI] + (size_t)l * DM * NUP, DM, NUP, A->in[I_FFN2_NORM] + l * DM, Wb + WO_UP2, scr, r, lane); continue; } r -= I_UP;
            if (r < I_DN) { cvt_item<0>(A->in[I_FFN2_WO] + (size_t)l * FF * DM, FF, DM, nullptr, Wb + WO_DN2, scr, r, lane); continue; } r -= I_DN;
            if (r < I_A) { cvt_item<0>(A->in[I_W_A] + (size_t)l * 512 * DM, 512, DM, nullptr, Wb + WO_A, scr, r, lane, DM, 0); continue; } r -= I_A;
            if (r < I_A) { cvt_item<0>(A->in[I_W_B] + (size_t)l * 512 * DM, 512, DM, nullptr, Wb + WO_A, scr, r, lane, DM, 512); continue; } r -= I_A;
            if (r < I_OUT) { cvt_item<0>(A->in[I_W_OUT] + (size_t)l * DM * DM, DM, DM, nullptr, Wb + WO_OUT, scr, r, lane); continue; } r -= I_OUT;
            if (r < I_OUT) { cvt_item<0>(A->in[I_W_PG] + (size_t)l * DM * DM, DM, DM, A->in[I_PLE_NORM] + l * DM, Wb + WO_PG, scr, r, lane); continue; } r -= I_OUT;
            cvt_item<0>(A->in[I_W_PLE] + (size_t)l * PD * DM, PD, DM, nullptr, Wb + WO_PLE, scr, r, lane); continue; }
        r -= nB; { const int l = la;
            if (r < I_UP) { cvt_item<1>(A->in[I_FFN1_WI] + (size_t)l * DM * NUP, DM, NUP, A->in[I_FFN1_NORM] + l * DM, Wb + WO_UP1, scr, r, lane); continue; } r -= I_UP;
            if (r < I_DN) { cvt_item<0>(A->in[I_FFN1_WO] + (size_t)l * FF * DM, FF, DM, nullptr, Wb + WO_DN1, scr, r, lane); continue; } r -= I_DN;
            cvt_item<2>(A->in[I_W_IN] + (size_t)l * DM * DIN, DM, DIN, A->in[I_MIX_NORM] + l * DM, Wb + WO_IN, scr, r, lane); }
    }
    const int gt = brank * 512 + tid, ngt = nblocks * 512;
    if (la >= 0) {
        bf16* wi = Wb + WO_IN + (size_t)(ZC_IF + 8) * DM; const int nz = (NIN - ZC_IF - 8) * DM / 8;
        const int c0 = (int)((long)nz * w0 / 256), c1 = (int)((long)nz * w1 / 256);
        for (int i = c0 + gt; i < c1; i += ngt) *(GAS v4u*)(wi + (size_t)i * 8) = (v4u){0u, 0u, 0u, 0u};
    }
    if (lb >= 0) {
        const float* pl = A->in[I_P] + (size_t)lb * M * PD; bf16* pb = (bf16*)(ws + WS_PB); const int nch = M * PD / 8;
        const int c0 = (int)((long)nch * w0 / 256), c1 = (int)((long)nch * w1 / 256);
        for (int i = c0 + gt; i < c1; i += ngt) { const f32x4 a = *(const GAS f32x4*)(pl + (size_t)i * 8), b = *(const GAS f32x4*)(pl + (size_t)i * 8 + 4);
            v4u o; o.x = pk2(a.x, a.y); o.y = pk2(a.z, a.w); o.z = pk2(b.x, b.y); o.w = pk2(b.z, b.w); *(GAS v4u*)(pb + (size_t)i * 8) = o; }
    }
}
__device__ __forceinline__ void phase_prologue(KArgs ka, LAS unsigned char* lds, int G) {
    convert_part(ka, lds, -1, 0, (int)blockIdx.x, G, 0, 256);
    PHASE_ENTRY(ka);
    const int lane = tid & 63, wave = tid >> 6;
    const int gw = blockIdx.x * NWAVES + wave, NGW = G * NWAVES;
    {
        bf16* xb = (bf16*)(ws + WS_XB0); float* ssa = (float*)(ws + WS_SSA);
        for (int m = gw; m < M; m += NGW) {
            const GAS f32x4* xr = (const GAS f32x4*)(A->in[I_X] + (size_t)m * DM) + lane;
            GAS unsigned long long* o8 = (GAS unsigned long long*)(xb + (size_t)m * DM) + lane;
            float s = 0.f;
#pragma unroll
            for (int j = 0; j < 4; ++j) { const f32x4 v = xr[64 * j]; s += (v.x * v.x + v.y * v.y) + (v.z * v.z + v.w * v.w);
                o8[64 * j] = (unsigned long long)pk2(v.x, v.y) | ((unsigned long long)pk2(v.z, v.w) << 32); }
            s = wave_sum(s);
            if (lane < 16) ssa[(size_t)m * 16 + lane] = (lane == 0) ? s : 0.f;
        }
        if (blockIdx.x == 0) { float* bt = (float*)(ws + WS_BT);
            for (int i = tid; i < 8 * 128; i += 512) { const int hq = i >> 7, dist = i & 127; bt[i] = A->in[I_REL_BIAS][(int)T5_BUCKET[dist] * 8 + hq]; } }
    }
}

__device__ __forceinline__ void mlstm_scan2(LAS unsigned char* lds, const int tid, const bf16* CLT, const float* Nst, float* GM, bf16* CPT, float* NP, int G) {
    LAS float* gl = (LAS float*)lds; LAS float* ml = gl + 64; LAS float* so = ml + 64; LAS float* sn = so + 64;
    for (int wi = blockIdx.x; wi < 128; wi += G) {
        const int bh = wi >> 2, qt = wi & 3, b = bh >> 2, h = bh & 3;
        if (tid < 64) { const size_t uid = (size_t)((b * 64 + tid) * 4 + h); gl[tid] = GM[uid * 4]; ml[tid] = GM[uid * 4 + 1]; }
        __syncthreads();
        if (tid == 0) { float mcur = 0.f;
            for (int c = 0; c < 64; ++c) { const float g = gl[c], mc = ml[c]; const float mn = fmaxf(g + mcur, mc);
                so[c] = expf(g + mcur - mn); sn[c] = expf(mc - mn); if (qt == 0) GM[(size_t)((b * 64 + c) * 4 + h) * 4 + 2] = mcur; mcur = mn; } }
        __syncthreads();
        const int e = 32 * qt + (tid >> 4), d0 = (tid & 15) * 4;
        float C0 = 0.f, C1 = 0.f, C2 = 0.f, C3 = 0.f;
        for (int c0 = 0; c0 < 64; c0 += 16) {
            u32x2 cv[16];
#pragma unroll
            for (int j = 0; j < 16; ++j) cv[j] = *(const u32x2*)(CLT + (size_t)((b * 64 + c0 + j) * 4 + h) * 8192 + (size_t)e * 64 + d0);
#pragma unroll
            for (int j = 0; j < 16; ++j) { const size_t uid = (size_t)((b * 64 + c0 + j) * 4 + h); const float s_o = so[c0 + j], s_n = sn[c0 + j];
                u32x2 w; w.x = pk2(C0, C1); w.y = pk2(C2, C3); *(u32x2*)(CPT + uid * 8192 + (size_t)e * 64 + d0) = w;
                C0 = s_o * C0 + s_n * bflo(cv[j].x); C1 = s_o * C1 + s_n * bfhi(cv[j].x); C2 = s_o * C2 + s_n * bflo(cv[j].y); C3 = s_o * C3 + s_n * bfhi(cv[j].y); }
        }
        if (qt == 0 && tid < 64) { float n = 0.f;
            for (int c0 = 0; c0 < 64; c0 += 8) { float nv[8];
#pragma unroll
                for (int j = 0; j < 8; ++j) nv[j] = Nst[(size_t)((b * 64 + c0 + j) * 4 + h) * 64 + tid];
#pragma unroll
                for (int j = 0; j < 8; ++j) { NP[(size_t)((b * 64 + c0 + j) * 4 + h) * 64 + tid] = n; n = so[c0 + j] * n + sn[c0 + j] * nv[j]; } } }
        __syncthreads();
    }
}

__device__ __forceinline__ void swa_unit_mfma(LAS unsigned char* lds, const int tid, int uid, const bf16* Z, const float* qgain, const float* kgain, const float* sinks, const float* bt, bf16* HB) {
    const int lane = tid & 63, wave = tid >> 6, c_in = lane & 15, g4_in = lane >> 4;
    const int kvh = uid & 1, nb = (uid >> 1) & 31, b = uid >> 6;
    LAS unsigned char* Ks = lds; LAS unsigned short* Vt = (LAS unsigned short*)(lds + 256 * 144); LAS float* bl = (LAS float*)(lds + 256 * 144 + 64 * 264 * 2);
#pragma unroll
    for (int i = 0; i < 4; ++i) { const int cc = tid + 512 * i, j = cc >> 3, ch = cc & 7; const bool ok = (nb > 0) || (j >= 128);
        const size_t krow = (size_t)b * SEQ + (size_t)(nb * 128 + j) - 128;
        u32x4 kq = (u32x4){0u, 0u, 0u, 0u}, vq = (u32x4){0u, 0u, 0u, 0u};
        const int jv = lane + 64 * i; const bool okv = (nb > 0) || (jv >= 128);
        if (ok) kq = *(const u32x4*)(Z + krow * NIN + ZC_SK + kvh * 64 + ch * 8);
        if (okv) vq = *(const u32x4*)(Z + ((size_t)b * SEQ + (size_t)(nb * 128 + jv) - 128) * NIN + ZC_SV + kvh * 64 + wave * 8);
        float kf[8]; unpack8(kq, kf); float ssq = 0.f;
#pragma unroll
        for (int e = 0; e < 8; ++e) ssq += kf[e] * kf[e];
        ssq += __shfl_xor(ssq, 1); ssq += __shfl_xor(ssq, 2); ssq += __shfl_xor(ssq, 4);
        const float rn = 1.0f / sqrtf(ssq * (1.0f / 64.0f) + EPSF);
#pragma unroll
        for (int e = 0; e < 8; ++e) kf[e] = kf[e] * rn * kgain[ch * 8 + e];
        *(LAS u32x4*)(Ks + j * 144 + ch * 16) = pack8f(kf);
        LAS unsigned short* vp = Vt + (wave * 8) * 264 + jv;
        vp[0 * 264] = (unsigned short)(vq.x & 0xffffu); vp[1 * 264] = (unsigned short)(vq.x >> 16); vp[2 * 264] = (unsigned short)(vq.y & 0xffffu); vp[3 * 264] = (unsigned short)(vq.y >> 16);
        vp[4 * 264] = (unsigned short)(vq.z & 0xffffu); vp[5 * 264] = (unsigned short)(vq.z >> 16); vp[6 * 264] = (unsigned short)(vq.w & 0xffffu); vp[7 * 264] = (unsigned short)(vq.w >> 16); }
    bl[tid] = bt[(kvh * 4 + (tid >> 7)) * 128 + (tid & 127)];
    __syncthreads();
    const int qg = wave;
    u32x4 qn0, qn1;
    { const bf16* qp = Z + ((size_t)b * SEQ + nb * 128 + qg * 16 + c_in) * NIN + ZC_SQ + (kvh * 4) * 64 + 8 * g4_in; qn0 = *(const u32x4*)qp; qn1 = *(const u32x4*)(qp + 32); }
    for (int g = 0; g < 4; ++g) {
        int c = c_in, g4 = g4_in; asm volatile("" : "+v"(c), "+v"(g4));
        const int hq = kvh * 4 + g, qi = qg * 16 + c; const size_t row = (size_t)b * SEQ + nb * 128 + qi;
        bf16x8_t qf[2];
        {
            float f0[8], f1[8];
            unpack8(qn0, f0); unpack8(qn1, f1);
            if (g + 1 < 4) { const bf16* qp = Z + row * NIN + ZC_SQ + (hq + 1) * 64 + 8 * g4; qn0 = *(const u32x4*)qp; qn1 = *(const u32x4*)(qp + 32); }
            float ssq = 0.f;
#pragma unroll
            for (int e = 0; e < 8; ++e) ssq += f0[e] * f0[e] + f1[e] * f1[e];
            ssq += __shfl_xor(ssq, 16); ssq += __shfl_xor(ssq, 32);
            const float rn = 0.125f / sqrtf(ssq * (1.0f / 64.0f) + EPSF);
#pragma unroll
            for (int e = 0; e < 8; ++e) { f0[e] = f0[e] * rn * qgain[8 * g4 + e]; f1[e] = f1[e] * rn * qgain[32 + 8 * g4 + e]; }
            qf[0] = __builtin_bit_cast(bf16x8_t, pack8f(f0)); qf[1] = __builtin_bit_cast(bf16x8_t, pack8f(f1));
        }
        f32x4 sc[9];
        const float sink = sinks[hq]; float mx = sink;
        const LAS float* blg = bl + g * 128;
#pragma unroll
        for (int tt = 0; tt < 9; ++tt) { const int T = qg + tt;
            const LAS unsigned char* kp = Ks + (16 * T + c) * 144 + 16 * g4;
            const bf16x8_t ka0 = *(const LAS bf16x8_t*)kp, ka1 = *(const LAS bf16x8_t*)(kp + 64);
            f32x4 a = (f32x4){0.f, 0.f, 0.f, 0.f};
            a = __builtin_amdgcn_mfma_f32_16x16x32_bf16(ka0, qf[0], a, 0, 0, 0);
            a = __builtin_amdgcn_mfma_f32_16x16x32_bf16(ka1, qf[1], a, 0, 0, 0);
            const bool tile_ok = (nb > 0) || (T >= 8);
#pragma unroll
            for (int r = 0; r < 4; ++r) { const int dist = 128 + c - 16 * tt - 4 * g4 - r;
                bool valid = tile_ok; if (tt == 0) valid = valid && (dist < 128); if (tt == 8) valid = valid && (dist >= 0);
                const float s = a[r] + blg[dist & 127];
                a[r] = valid ? s : -INFINITY; mx = fmaxf(mx, a[r]); }
            sc[tt] = a; }
        mx = fmaxf(mx, __shfl_xor(mx, 16)); mx = fmaxf(mx, __shfl_xor(mx, 32));
        float ls = 0.f;
#pragma unroll
        for (int tt = 0; tt < 9; ++tt)
#pragma unroll
            for (int r = 0; r < 4; ++r) { const float p = __expf(sc[tt][r] - mx); sc[tt][r] = p; ls += p; }
        ls += __shfl_xor(ls, 16); ls += __shfl_xor(ls, 32);
        const float il = 1.0f / (ls + __expf(sink - mx));
        f32x4 o[4];
#pragma unroll
        for (int db = 0; db < 4; ++db) o[db] = (f32x4){0.f, 0.f, 0.f, 0.f};
#pragma unroll
        for (int pr = 0; pr < 5; ++pr) { const int t0 = 2 * pr, t1 = (pr < 4) ? 2 * pr + 1 : 8;
            u32x4 pw; pw.x = pk2(sc[t0][0], sc[t0][1]); pw.y = pk2(sc[t0][2], sc[t0][3]);
            if (pr < 4) { pw.z = pk2(sc[t1][0], sc[t1][1]); pw.w = pk2(sc[t1][2], sc[t1][3]); } else { pw.z = 0u; pw.w = 0u; }
            const bf16x8_t pf = __builtin_bit_cast(bf16x8_t, pw);
#pragma unroll
            for (int db = 0; db < 4; ++db) { const LAS unsigned short* vp = Vt + (16 * db + c) * 264 + 4 * g4;
                const u32x2 lo = *(const LAS u32x2*)(vp + 16 * (qg + t0)), hi = *(const LAS u32x2*)(vp + 16 * (qg + t1));
                const bf16x8_t vf = __builtin_bit_cast(bf16x8_t, (u32x4){lo.x, lo.y, hi.x, hi.y});
                o[db] = __builtin_amdgcn_mfma_f32_16x16x32_bf16(vf, pf, o[db], 0, 0, 0); } }
        bf16* hp = HB + row * 1024 + hq * 64 + 4 * g4;
#pragma unroll
        for (int db = 0; db < 4; ++db) { u32x2 w; w.x = pk2(o[db][0] * il, o[db][1] * il); w.y = pk2(o[db][2] * il, o[db][3] * il); *(u32x2*)(hp + 16 * db) = w; }
    }
    __syncthreads();
}

__device__ __forceinline__ void mlstm_local_phase(LAS unsigned char* lds, const int tid, int bx, int G, const bf16* Z, const float* IFb, bf16* CLT, float* Nst, float* GM) {
    const int lane = tid & 63, wave = tid >> 6;
    LAS unsigned short* KwT = (LAS unsigned short*)lds;
    LAS unsigned short* VT = KwT + 64 * 72;
    LAS float* wv_all = (LAS float*)(lds + (64 + 128) * 144);
    for (int base = bx; base < NUNIT_ML; base += 8 * G) {
        { const int uid = base + wave * G;
          if (uid < NUNIT_ML) { const int h = uid & 3; const size_t row0 = (size_t)(uid >> 2) * 64;
            const float ip = IFb[(row0 + lane) * 8 + h], fp = IFb[(row0 + lane) * 8 + 4 + h];
            const float lf = logsigmoidf_(fp);
            const float bc = wave_incl_sum(lf, lane);
            const float g = __shfl(bc, 63);
            const float a = g - bc + ip;
            const float ml = wave_max(a);
            wv_all[wave * 64 + lane] = expf(a - ml);
            if (lane == 0) { GM[uid * 4 + 0] = g; GM[uid * 4 + 1] = ml; } } }
        const int t = lane, ch = wave;
        u32x4 kq, v0, v1;
        { const int uid = base; const int h = uid & 3; const bf16* zr = Z + ((size_t)(uid >> 2) * 64 + t) * NIN;
          kq = *(const u32x4*)(zr + ZC_MK + h * 64 + ch * 8); v0 = *(const u32x4*)(zr + ZC_MV + h * 128 + ch * 8); v1 = *(const u32x4*)(zr + ZC_MV + h * 128 + 64 + ch * 8); }
        __syncthreads();
        for (int i = 0; i < 8; ++i) {
            const int uid = base + i * G; if (uid >= NUNIT_ML) break;
            {
                const float w = wv_all[i * 64 + t] * 0.125f; float f[8]; unpack8(kq, f);
#pragma unroll
                for (int e = 0; e < 8; ++e) KwT[(ch * 8 + e) * 72 + t] = (unsigned short)f2bf(w * f[e]);
                LAS unsigned short* p0 = VT + (ch * 8) * 72 + t; LAS unsigned short* p1 = VT + (64 + ch * 8) * 72 + t;
                p0[0 * 72] = (unsigned short)(v0.x & 0xffffu); p0[1 * 72] = (unsigned short)(v0.x >> 16); p0[2 * 72] = (unsigned short)(v0.y & 0xffffu); p0[3 * 72] = (unsigned short)(v0.y >> 16);
                p0[4 * 72] = (unsigned short)(v0.z & 0xffffu); p0[5 * 72] = (unsigned short)(v0.z >> 16); p0[6 * 72] = (unsigned short)(v0.w & 0xffffu); p0[7 * 72] = (unsigned short)(v0.w >> 16);
                p1[0 * 72] = (unsigned short)(v1.x & 0xffffu); p1[1 * 72] = (unsigned short)(v1.x >> 16); p1[2 * 72] = (unsigned short)(v1.y & 0xffffu); p1[3 * 72] = (unsigned short)(v1.y >> 16);
                p1[4 * 72] = (unsigned short)(v1.z & 0xffffu); p1[5 * 72] = (unsigned short)(v1.z >> 16); p1[6 * 72] = (unsigned short)(v1.w & 0xffffu); p1[7 * 72] = (unsigned short)(v1.w >> 16);
            }
            __syncthreads();
            { const int un = uid + G;
              if (i + 1 < 8 && un < NUNIT_ML) { const int h = un & 3; const bf16* zr = Z + ((size_t)(un >> 2) * 64 + t) * NIN;
                kq = *(const u32x4*)(zr + ZC_MK + h * 64 + ch * 8); v0 = *(const u32x4*)(zr + ZC_MV + h * 128 + ch * 8); v1 = *(const u32x4*)(zr + ZC_MV + h * 128 + 64 + ch * 8); } }
            {
                int c = lane & 15, g4 = lane >> 4; asm volatile("" : "+v"(c), "+v"(g4));
                const LAS unsigned short* vp = VT + (16 * wave + c) * 72 + 8 * g4;
                const bf16x8_t vb0 = *(const LAS bf16x8_t*)vp, vb1 = *(const LAS bf16x8_t*)(vp + 32);
                bf16* cbase = CLT + (size_t)uid * 8192 + (size_t)(16 * wave + c) * 64 + 4 * g4;
#pragma unroll
                for (int dt = 0; dt < 4; ++dt) { const LAS unsigned short* kp = KwT + (16 * dt + c) * 72 + 8 * g4;
                    const bf16x8_t ka0 = *(const LAS bf16x8_t*)kp, ka1 = *(const LAS bf16x8_t*)(kp + 32);
                    f32x4 a = (f32x4){0.f, 0.f, 0.f, 0.f};
                    a = __builtin_amdgcn_mfma_f32_16x16x32_bf16(ka0, vb0, a, 0, 0, 0);
                    a = __builtin_amdgcn_mfma_f32_16x16x32_bf16(ka1, vb1, a, 0, 0, 0);
                    u32x2 w; w.x = pk2(a[0], a[1]); w.y = pk2(a[2], a[3]); *(u32x2*)(cbase + 16 * dt) = w; }
            }
            if (tid < 64) { float s = 0.f; const LAS unsigned* kr = (const LAS unsigned*)(KwT + tid * 72);
#pragma unroll 8
                for (int t2 = 0; t2 < 32; ++t2) { const unsigned w2 = kr[t2]; s += bflo(w2) + bfhi(w2); }
                Nst[(size_t)uid * 64 + tid] = s; }
            __syncthreads();
        }
    }
}

__device__ __forceinline__ void mlstm_out_phase(LAS unsigned char* lds, const int tid, int bx, int G, const bf16* Z, const float* IFb, const bf16* CPT, const float* NP, const float* GM, const float* gain, bf16* HA) {
    const int lane = tid & 63, wave = tid >> 6;
    constexpr int QS = 0, KS = 9216, VTO = 18432, CTO = 36864, UB = 55296, VECALL = 2 * UB, VSTR = 384;
    constexpr int NPAIR = NUNIT_ML / 2;
    for (int base = bx; base < NPAIR; base += 4 * G) {
        { const int pair = base + (wave >> 1) * G, sub = wave & 1;
          if (pair < NPAIR) { const int uid = 2 * pair + sub, h = uid & 3; const size_t row0 = (size_t)(pair >> 1) * 64; LAS float* vec = (LAS float*)(lds + VECALL) + wave * VSTR;
            const float ip = IFb[(row0 + lane) * 8 + h], fp = IFb[(row0 + lane) * 8 + 4 + h];
            const float lf = logsigmoidf_(fp);
            const float bc = wave_incl_sum(lf, lane);
            const float pmx = wave_incl_max(ip - bc, lane);
            const float mprev = GM[uid * 4 + 2];
            const float ee = bc + mprev;
            const float mtv = fmaxf(bc + pmx, ee);
            vec[lane] = bc - mtv; vec[64 + lane] = ip - bc; vec[128 + lane] = expf(ee - mtv); vec[192 + lane] = NP[(size_t)uid * 64 + lane]; vec[256 + lane] = expf(-mtv); } }
        const int ts = tid >> 3, ch = tid & 7;
        u32x4 rq[2], rk[2], rv0[2], rv1[2], rc0[2], rc1[2];
#define MO_LOAD(pair_) do { const size_t row0_ = (size_t)((pair_) >> 1) * 64; \
            _Pragma("unroll") for (int u = 0; u < 2; ++u) { const int uid_ = 2 * (pair_) + u, h_ = uid_ & 3; const bf16* zr = Z + (row0_ + ts) * NIN; \
                rq[u] = *(const u32x4*)(zr + ZC_MQ + h_ * 64 + ch * 8); rk[u] = *(const u32x4*)(zr + ZC_MK + h_ * 64 + ch * 8); \
                { const bf16* zv = Z + (row0_ + lane) * NIN + ZC_MV + h_ * 128 + wave * 8; rv0[u] = *(const u32x4*)zv; rv1[u] = *(const u32x4*)(zv + 64); }     \
                const u32x4* cg = (const u32x4*)(CPT + (size_t)uid_ * 8192); rc0[u] = cg[tid]; rc1[u] = cg[tid + 512]; } } while (0)
        MO_LOAD(base);
        __syncthreads();
        for (int i = 0; i < 4; ++i) {
            const int pair = base + i * G; if (pair >= NPAIR) break;
            const size_t row0 = (size_t)(pair >> 1) * 64;
#pragma unroll
            for (int u = 0; u < 2; ++u) { LAS unsigned char* ub = lds + u * UB;
                *(LAS u32x4*)(ub + QS + ts * 144 + ch * 16) = rq[u];
                { float f[8]; unpack8(rk[u], f);
#pragma unroll
                  for (int e = 0; e < 8; ++e) f[e] *= 0.125f;
                  *(LAS u32x4*)(ub + KS + ts * 144 + ch * 16) = pack8f(f); }
                const u32x4 v0 = rv0[u], v1 = rv1[u];
                LAS unsigned short* p0 = (LAS unsigned short*)(ub + VTO) + (wave * 8) * 72 + lane; LAS unsigned short* p1 = p0 + 64 * 72;
                p0[0 * 72] = (unsigned short)(v0.x & 0xffffu); p0[1 * 72] = (unsigned short)(v0.x >> 16); p0[2 * 72] = (unsigned short)(v0.y & 0xffffu); p0[3 * 72] = (unsigned short)(v0.y >> 16);
                p0[4 * 72] = (unsigned short)(v0.z & 0xffffu); p0[5 * 72] = (unsigned short)(v0.z >> 16); p0[6 * 72] = (unsigned short)(v0.w & 0xffffu); p0[7 * 72] = (unsigned short)(v0.w >> 16);
                p1[0 * 72] = (unsigned short)(v1.x & 0xffffu); p1[1 * 72] = (unsigned short)(v1.x >> 16); p1[2 * 72] = (unsigned short)(v1.y & 0xffffu); p1[3 * 72] = (unsigned short)(v1.y >> 16);
                p1[4 * 72] = (unsigned short)(v1.z & 0xffffu); p1[5 * 72] = (unsigned short)(v1.z >> 16); p1[6 * 72] = (unsigned short)(v1.w & 0xffffu); p1[7 * 72] = (unsigned short)(v1.w >> 16);
                { const int e0 = tid >> 3, d0 = tid & 7; *(LAS u32x4*)(ub + CTO + e0 * 144 + d0 * 16) = rc0[u]; *(LAS u32x4*)(ub + CTO + (e0 + 64) * 144 + d0 * 16) = rc1[u]; }
            }
            __syncthreads();
            { const int pn = pair + G; if (i + 1 < 4 && pn < NPAIR) MO_LOAD(pn); }
            {
                const int sub = wave >> 2, tt = wave & 3; int c = lane & 15, g4 = lane >> 4; asm volatile("" : "+v"(c), "+v"(g4));
                const int uid = 2 * pair + sub, h = uid & 3; const LAS unsigned char* ub = lds + sub * UB; const LAS float* vec = (const LAS float*)(lds + VECALL) + (2 * i + sub) * VSTR;
                const int t = 16 * tt + c;
                const LAS unsigned char* qp = ub + QS + t * 144 + 16 * g4;
                const bf16x8_t qf0 = *(const LAS bf16x8_t*)qp, qf1 = *(const LAS bf16x8_t*)(qp + 64);
                const float bmt = vec[t], sint = vec[128 + t], emt = vec[256 + t];
                f32x4 wt[4]; float dsum = 0.f;
#pragma unroll
                for (int st = 0; st < 4; ++st) {
                    if (st <= tt) { const LAS unsigned char* kp = ub + KS + (16 * st + c) * 144 + 16 * g4;
                        const bf16x8_t ka0 = *(const LAS bf16x8_t*)kp, ka1 = *(const LAS bf16x8_t*)(kp + 64);
                        f32x4 a = (f32x4){0.f, 0.f, 0.f, 0.f};
                        a = __builtin_amdgcn_mfma_f32_16x16x32_bf16(ka0, qf0, a, 0, 0, 0);
                        a = __builtin_amdgcn_mfma_f32_16x16x32_bf16(ka1, qf1, a, 0, 0, 0);
                        const f32x4 us4 = *(const LAS f32x4*)(vec + 64 + 16 * st + 4 * g4);
#pragma unroll
                        for (int r = 0; r < 4; ++r) { const int s = 16 * st + 4 * g4 + r; const float w = (s <= t) ? __expf(bmt + us4[r]) * a[r] : 0.f; a[r] = w; dsum += w; }
                        wt[st] = a;
                    } else wt[st] = (f32x4){0.f, 0.f, 0.f, 0.f};
                }
                dsum += __shfl_xor(dsum, 16); dsum += __shfl_xor(dsum, 32);
                float qn = 0.f;
                { float f0[8], f1[8]; unpack8(__builtin_bit_cast(u32x4, qf0), f0); unpack8(__builtin_bit_cast(u32x4, qf1), f1);
                  const LAS f32x4* np = (const LAS f32x4*)(vec + 192 + 8 * g4); const f32x4 n0 = np[0], n1 = np[1], n2 = np[8], n3 = np[9];
                  qn = f0[0] * n0.x + f0[1] * n0.y + f0[2] * n0.z + f0[3] * n0.w + f0[4] * n1.x + f0[5] * n1.y + f0[6] * n1.z + f0[7] * n1.w
                     + f1[0] * n2.x + f1[1] * n2.y + f1[2] * n2.z + f1[3] * n2.w + f1[4] * n3.x + f1[5] * n3.y + f1[6] * n3.z + f1[7] * n3.w; }
                qn += __shfl_xor(qn, 16); qn += __shfl_xor(qn, 32);
                const float den = dsum + sint * qn; const float inv = 1.0f / fmaxf(fabsf(den), emt);
                u32x4 pwa, pwb;
                pwa.x = pk2(wt[0][0], wt[0][1]); pwa.y = pk2(wt[0][2], wt[0][3]); pwa.z = pk2(wt[1][0], wt[1][1]); pwa.w = pk2(wt[1][2], wt[1][3]);
                pwb.x = pk2(wt[2][0], wt[2][1]); pwb.y = pk2(wt[2][2], wt[2][3]); pwb.z = pk2(wt[3][0], wt[3][1]); pwb.w = pk2(wt[3][2], wt[3][3]);
                const bf16x8_t pf0 = __builtin_bit_cast(bf16x8_t, pwa), pf1 = __builtin_bit_cast(bf16x8_t, pwb);
                f32x4 hv[8]; float ssq = 0.f;
#pragma unroll
                for (int et = 0; et < 8; ++et) {
                    const LAS unsigned short* vp = (const LAS unsigned short*)(ub + VTO) + (16 * et + c) * 72 + 4 * g4;
                    const u32x2 l0 = *(const LAS u32x2*)vp, h0 = *(const LAS u32x2*)(vp + 16);
                    f32x4 a1 = (f32x4){0.f, 0.f, 0.f, 0.f};
                    a1 = __builtin_amdgcn_mfma_f32_16x16x32_bf16(__builtin_bit_cast(bf16x8_t, (u32x4){l0.x, l0.y, h0.x, h0.y}), pf0, a1, 0, 0, 0);
                    if (tt >= 2) { const u32x2 l1 = *(const LAS u32x2*)(vp + 32), h1 = *(const LAS u32x2*)(vp + 48);
                        a1 = __builtin_amdgcn_mfma_f32_16x16x32_bf16(__builtin_bit_cast(bf16x8_t, (u32x4){l1.x, l1.y, h1.x, h1.y}), pf1, a1, 0, 0, 0); }
                    const LAS unsigned char* cp = ub + CTO + (16 * et + c) * 144 + 16 * g4;
                    const bf16x8_t cf0 = *(const LAS bf16x8_t*)cp, cf1 = *(const LAS bf16x8_t*)(cp + 64);
                    f32x4 a2 = (f32x4){0.f, 0.f, 0.f, 0.f};
                    a2 = __builtin_amdgcn_mfma_f32_16x16x32_bf16(cf0, qf0, a2, 0, 0, 0);
                    a2 = __builtin_amdgcn_mfma_f32_16x16x32_bf16(cf1, qf1, a2, 0, 0, 0);
#pragma unroll
                    for (int r = 0; r < 4; ++r) { const float x = (a1[r] + sint * a2[r]) * inv; a1[r] = x; ssq += x * x; }
                    hv[et] = a1;
                }
                ssq += __shfl_xor(ssq, 16); ssq += __shfl_xor(ssq, 32);
                const float rn = 1.0f / sqrtf(ssq * (1.0f / 128.0f) + EPSF);
                const bf16* zo = Z + (row0 + t) * NIN + ZC_MO + h * 128 + 4 * g4; const float* gp = gain + h * 128 + 4 * g4; bf16* hp = HA + (row0 + t) * 1024 + h * 128 + 4 * g4;
#pragma unroll
                for (int et = 0; et < 8; ++et) { const u32x2 ow = *(const u32x2*)(zo + 16 * et); const f32x4 gn = *(const f32x4*)(gp + 16 * et);
                    u32x2 w; w.x = pk2(hv[et][0] * rn * gn.x * bflo(ow.x), hv[et][1] * rn * gn.y * bfhi(ow.x)); w.y = pk2(hv[et][2] * rn * gn.z * bflo(ow.y), hv[et][3] * rn * gn.w * bfhi(ow.y));
                    *(u32x2*)(hp + 16 * et) = w; }
            }
            __syncthreads();
        }
#undef MO_LOAD
    }
}

__device__ __forceinline__ pg8::RowTab build_rowtab(LAS unsigned char* lds, const int tid, const float* ss, const pg8::StaticOrder& S) {
    pg8::Unit u0; LAS float* tab = (LAS float*)(lds + RTAB_OFF); pg8::RowTab T; T.tab = tab; T.ss = ss; T.pm_hi = -1;
    if (S.next(0, u0)) { T.pm_hi = u0.pm | 8;
        const int slot = tid >> 8, r = tid & 255, pm = (u0.pm & ~8) + 8 * slot;
        float rs = 0.f;
        if (pm < S.nM) { const f32x4* p = (const f32x4*)(ss + ((size_t)pm * 256 + r) * 16); const f32x4 a = p[0], b = p[1], c = p[2], d = p[3];
            const float s = ((a[0] + a[1]) + (a[2] + a[3])) + ((b[0] + b[1]) + (b[2] + b[3])) + ((c[0] + c[1]) + (c[2] + c[3])) + ((d[0] + d[1]) + (d[2] + d[3]));
            rs = __builtin_amdgcn_rsqf(s * (1.0f / 1024.0f) + 1e-6f); }
        tab[tid] = rs; }
    __syncthreads();
    return T;
}

#ifndef SWA_UNIT
#define SWA_UNIT swa_unit_mfma
#endif
#ifndef CVT_SPLIT
#define CVT_SPLIT 192
#endif
__global__ void __launch_bounds__(NWAVES * 64, 2) fwd_kernel(Args args_unused) {
    extern __shared__ __attribute__((aligned(16))) unsigned char lds_raw[];
    LAS unsigned char* lds = (LAS unsigned char*)lds_raw;
    const KArgs ka = (KArgs)__builtin_amdgcn_kernarg_segment_ptr();
    const int G = gridDim.x, bx = (int)blockIdx.x;
    for (int u = threadIdx.x; u < (LDS_BYTES - LDSCTL_OFF) / 4; u += NWAVES * 64) ((LAS unsigned*)(lds + LDSCTL_OFF))[u] = 0u;
    __syncthreads();
    volatile LAS unsigned* MISC = (volatile LAS unsigned*)(lds + MISC_OFF);
    const int lo = ka->ph_lo, hi = ka->ph_hi;
    XcdBarrier bar; bar.bar = (unsigned*)((gu32*)(ka->ws + WS_CTL) + CW_BAR) + ka->li * XCD_BAR_WORDS; bar.x = 0; bar.st = nullptr;
    if (hi - lo > 1) bar = xcd_barrier_post(bar.bar, MISC + 8);
#define IN(k) (lo <= (k) && (k) < hi)
#define SEAM(k) do { if (IN((k) + 1)) xcd_barrier(bar); } while (0)
#define WSP(T, off) ((T*)(ws + (off)))

    for (int l = 0; l < DEPTH; ++l) {
        const int pb = 12 * l;
        if (l == 0 && IN(pb + 0)) { phase_prologue(ka, lds, G); SEAM(pb + 0); }
        if (IN(pb + 1)) {
            PHASE_ENTRY(ka);
            pg8::Gemm g{WSP(bf16, WS_XB0), WSP(bf16, WS_W) + WO_UP1, M, NUP, DM}; pg8::StaticOrder S; S.init(M, NUP, G, bx);
            pg8::EpiUp E{WSP(bf16, WS_H), FF, build_rowtab(lds, tid, WSP(float, WS_SSA), S)};
            pg8::gemm_phase<pg8::EpiUp, pg8::StaticOrder, true, true>(lds + RING_OFF, g, S, E);
            SEAM(pb + 1);
        }
        if (IN(pb + 2)) {
            PHASE_ENTRY(ka);
            pg8::Gemm g{WSP(bf16, WS_H), WSP(bf16, WS_W) + WO_DN1, M, DM, FF}; pg8::StaticOrder S; S.init(M, DM, G, bx);
            pg8::EpiRes<0> E{WSP(bf16, WS_XB0), WSP(bf16, WS_XB0), WSP(float, WS_SSB), 0.5f, nullptr, nullptr, nullptr};
            pg8::gemm_phase<pg8::EpiRes<0>, pg8::StaticOrder, true, true>(lds + RING_OFF, g, S, E);
            SEAM(pb + 2);
        }
        if (IN(pb + 3)) {
            PHASE_ENTRY(ka);
            pg8::Gemm g{WSP(bf16, WS_XB0), WSP(bf16, WS_W) + WO_IN, M, NIN, DM}; pg8::StaticOrder S; S.init(M, NIN, G, bx);
            pg8::EpiIn E{WSP(bf16, WS_Z), NIN, build_rowtab(lds, tid, WSP(float, WS_SSB), S), WSP(float, WS_IF), A->in[I_B_I] + l * 4, A->in[I_B_F] + l * 4};
            pg8::gemm_phase<pg8::EpiIn, pg8::StaticOrder, true, true>(lds + RING_OFF, g, S, E);
            SEAM(pb + 3);
        }
        if (IN(pb + 4)) {
            { PHASE_ENTRY(ka);
              mlstm_local_phase(lds, tid, bx, G, WSP(bf16, WS_Z), WSP(float, WS_IF), WSP(bf16, WS_CST), WSP(float, WS_NST), WSP(float, WS_GM)); }
            { PHASE_ENTRY(ka);
              for (int u = bx; u < NUNIT_SW; u += G) SWA_UNIT(lds, tid, u, WSP(bf16, WS_Z), A->in[I_Q_NORM] + l * 64, A->in[I_K_NORM] + l * 64, A->in[I_SINKS] + l * 8, WSP(float, WS_BT), WSP(bf16, WS_HA) + 512); }
            SEAM(pb + 4);
        }
        if (IN(pb + 5)) {
            const int la = (l + 1 < DEPTH) ? l + 1 : -1; const int half = G >> 1;
            if (G >= 256 && bx >= half) convert_part(ka, lds, l, la, bx - half, G - half, 0, CVT_SPLIT);
            else { { PHASE_ENTRY(ka); mlstm_scan2(lds, tid, WSP(bf16, WS_CST), WSP(float, WS_NST), WSP(float, WS_GM), WSP(bf16, WS_CPT), WSP(float, WS_NP), G >= 256 ? half : G); }
                   if (G >= 256) convert_part(ka, lds, l, la, bx, half, CVT_SPLIT, 256); else convert_part(ka, lds, l, la, bx, G, 0, 256); }
            SEAM(pb + 5);
        }
        if (IN(pb + 6)) {
            PHASE_ENTRY(ka);
            mlstm_out_phase(lds, tid, bx, G, WSP(bf16, WS_Z), WSP(float, WS_IF), WSP(bf16, WS_CPT), WSP(float, WS_NP), WSP(float, WS_GM), A->in[I_ML_NORM] + l * 512, WSP(bf16, WS_HA));
            SEAM(pb + 6);
        }
        if (IN(pb + 7)) {
            PHASE_ENTRY(ka);
            pg8::Gemm g{WSP(bf16, WS_HA), WSP(bf16, WS_W) + WO_A, M, DM, DM}; pg8::StaticOrder S; S.init(M, DM, G, bx);
            pg8::EpiMixH E{WSP(bf16, WS_MIX), WSP(bf16, WS_Z), NIN};
            pg8::gemm_phase<pg8::EpiMixH, pg8::StaticOrder, true, true, true>(lds + RING_OFF, g, S, E);
            SEAM(pb + 7);
        }
        if (IN(pb + 8)) {
            PHASE_ENTRY(ka);
            pg8::Gemm g{WSP(bf16, WS_MIX), WSP(bf16, WS_W) + WO_OUT, M, DM, DM}; pg8::StaticOrder S; S.init(M, DM, G, bx);
            pg8::EpiRes<0> E{WSP(bf16, WS_XB0), WSP(bf16, WS_XB0), WSP(float, WS_SSA), 1.0f, nullptr, nullptr, nullptr};
            pg8::gemm_phase<pg8::EpiRes<0>, pg8::StaticOrder, true, true>(lds + RING_OFF, g, S, E);
            SEAM(pb + 8);
        }
        if (IN(pb + 9)) {
            PHASE_ENTRY(ka);
            pg8::Gemm g{WSP(bf16, WS_XB0), WSP(bf16, WS_W) + WO_UP2, M, NUP, DM}; pg8::StaticOrder S; S.init(M, NUP, G, bx);
            pg8::EpiUp E{WSP(bf16, WS_H), FF, build_rowtab(lds, tid, WSP(float, WS_SSA), S)};
            pg8::gemm_phase<pg8::EpiUp, pg8::StaticOrder, true, true>(lds + RING_OFF, g, S, E);
            SEAM(pb + 9);
        }
        if (IN(pb + 10)) {
            PHASE_ENTRY(ka);
            pg8::Gemm g{WSP(bf16, WS_H), WSP(bf16, WS_W) + WO_DN2, M, DM, FF}; pg8::StaticOrder S; S.init(M, DM, G, bx);
            pg8::EpiRes<0> E{WSP(bf16, WS_XB0), WSP(bf16, WS_XB1), WSP(float, WS_SSB), 0.5f, nullptr, nullptr, nullptr};
            pg8::gemm_phase<pg8::EpiRes<0>, pg8::StaticOrder, true, true>(lds + RING_OFF, g, S, E);
            SEAM(pb + 10);
        }
        if (IN(pb + 11)) {
            { PHASE_ENTRY(ka);
              int kpe = PD; asm volatile("" : "+s"(kpe));
              pg8::Gemm g{WSP(bf16, WS_PB), WSP(bf16, WS_W) + WO_PLE, M, DM, kpe}; pg8::StaticOrder S; S.init(M, DM, G, bx);
              pg8::EpiPlain E{WSP(bf16, WS_PE), DM};
              pg8::gemm_phase<pg8::EpiPlain, pg8::StaticOrder, true, true>(lds + RING_OFF, g, S, E); }
            { PHASE_ENTRY(ka);
              pg8::Gemm g{WSP(bf16, WS_XB1), WSP(bf16, WS_W) + WO_PG, M, DM, DM}; pg8::StaticOrder S; S.init(M, DM, G, bx);
              pg8::EpiRes<1> E{WSP(bf16, WS_XB1), WSP(bf16, WS_XB0), WSP(float, WS_SSA), 1.0f, WSP(float, WS_SSB), WSP(bf16, WS_PE), (l == DEPTH - 1) ? A->out : nullptr};
              pg8::gemm_phase<pg8::EpiRes<1>, pg8::StaticOrder, true, true>(lds + RING_OFF, g, S, E); }
            SEAM(pb + 11);
        }
    }
#undef IN
#undef SEAM
#undef WSP
}

extern "C" void kernel_launch(void* const* d_in, const int* in_sizes, int n_in, void* d_out, int out_size, void* d_ws, size_t ws_size, hipStream_t stream) {
    static int grid = 0;
    if (grid == 0) {
        if (n_in != 23 || in_sizes[0] != M * DM || out_size != M * DM || ws_size < WS_END) { fprintf(stderr, "kernel_launch: unexpected shapes: n_in %d in0 %d out %d ws %zu (need %zu)\n", n_in, n_in > 0 ? in_sizes[0] : -1, out_size, ws_size, (size_t)WS_END); grid = -1; return; }
        int dev = 0, cus = 0, per_cu = 0;
        if (hipGetDevice(&dev) != hipSuccess || hipDeviceGetAttribute(&cus, hipDeviceAttributeMultiprocessorCount, dev) != hipSuccess) { fprintf(stderr, "kernel_launch: device query failed\n"); grid = -1; return; }
        if (hipFuncSetAttribute((const void*)fwd_kernel, hipFuncAttributeMaxDynamicSharedMemorySize, LDS_BYTES) != hipSuccess) { fprintf(stderr, "kernel_launch: hipFuncSetAttribute failed\n"); grid = -1; return; }
        if (hipOccupancyMaxActiveBlocksPerMultiprocessor(&per_cu, (const void*)fwd_kernel, NWAVES * 64, LDS_BYTES) != hipSuccess || per_cu < 1) fprintf(stderr, "kernel_launch: occupancy query reports %d blocks per CU\n", per_cu);
        (void)hipGetLastError();
        grid = cus < 256 ? cus : 256;
        if (grid != 256) fprintf(stderr, "kernel_launch: %d CUs; this kernel is laid out for 256\n", cus);
    }
    if (grid < 0) return;
    if (hipMemsetAsync((char*)d_ws + WS_CTL, 0, CTL_ZERO_BYTES, stream) != hipSuccess) { fprintf(stderr, "kernel_launch: memset failed\n"); return; }
    Args a{};
    for (int i = 0; i < 23; ++i) a.in[i] = (const float*)d_in[i];
    a.out = (float*)d_out; a.ws = (unsigned char*)d_ws; a.pad = 0;
    constexpr int NL = MK_N_LAUNCHES;
    for (int li = 0; li < NL; ++li) {
        a.ph_lo = (int)((long)NPHASE * li / NL); a.ph_hi = (int)((long)NPHASE * (li + 1) / NL); a.li = li;
        hipLaunchKernelGGL(fwd_kernel, dim3(grid), dim3(NWAVES * 64), LDS_BYTES, stream, a);
        const hipError_t le = hipPeekAtLastError();
        if (le != hipSuccess) { fprintf(stderr, "kernel_launch: launch %d failed: %s\n", li, hipGetErrorName(le)); break; }
    }
}
```

```cpp
#define MK_N_LAUNCHES 1
#include <hip/hip_runtime.h>
#include <cstdio>
#include <cstdint>
#include <cmath>
namespace pg8 {
#define PG8_LAS __attribute__((address_space(3)))
typedef unsigned short bf16_t;
typedef short bf16x8 __attribute__((ext_vector_type(8)));
typedef float f32x4 __attribute__((ext_vector_type(4)));
typedef unsigned u32x4 __attribute__((ext_vector_type(4)));
constexpr int BM = 256, BK = 64, HALF = 128, HTB = HALF * BK * 2  , STAGE_BYTES = 8 * HTB, NXCD = 8, WGM = 8;

__host__ __device__ __forceinline__ int lds_byte(int r, int c) { const int st = (r >> 4) * 2 + (c >> 5), rr = r & 15, cc = c & 31, ob = rr * 64 + cc * 2; return st * 1024 + (ob ^ (((ob >> 9) & 1) << 5)); }
__host__ __device__ __forceinline__ void stage_rc(int b, int& R, int& C) { const int st = b / 1024, sb = b % 1024, swz = sb ^ (((sb >> 9) & 1) << 5); R = (st >> 1) * 16 + swz / 64; C = (st & 1) * 32 + (swz % 64) / 2; }
__host__ __device__ __forceinline__ int perm32(int rho) { const int n = rho >> 4, i = rho & 15; return 8 * (i >> 2) + 4 * n + (i & 3); }

struct Unit { int pm, pn; };
struct Gemm { const bf16_t* A; const bf16_t* Bt; int M, N, K; };

struct StaticOrder {
    int nM, nN, nwg, G, c, r0 = 0, r1 = 1 << 30, rev = 0;
    __host__ __device__ void init(int M, int N, int G_, int c_) { nM = M / BM; nN = N / BM; nwg = nM * nN; G = G_; c = c_; }
    __host__ __device__ bool next(int i, Unit& u) const {
        if (rev) { const int R = (nwg - c + G - 1) / G; i = R - 1 - i; if (i < 0) return false; }
        i += r0; if (i >= r1) return false;
        const long L = (long)i * G + c; if (L >= nwg) return false;
        int wgid = (int)L; { const int q = nwg / NXCD, r = nwg % NXCD, xcd = wgid % NXCD, off = wgid / NXCD; wgid = (xcd < r ? xcd * (q + 1) : r * (q + 1) + (xcd - r) * q) + off; }
        const int nig = WGM * nN, gid = wgid / nig, fm = gid * WGM, gsz = (nM - fm) < WGM ? (nM - fm) : WGM;
        u.pm = fm + ((wgid % nig) % gsz); u.pn = (wgid % nig) / gsz; return true;
    }
    __device__ __forceinline__ void a_ready(const Unit&) const {}
    __device__ __forceinline__ void done(const Unit&) const {}
};

typedef float f32x2 __attribute__((ext_vector_type(2)));
__device__ __forceinline__ unsigned cvt_pk_bf16(float lo, float hi) { unsigned r; asm volatile("v_cvt_pk_bf16_f32 %0, %1, %2" : "=v"(r) : "v"(lo), "v"(hi)); return r; }
__device__ __forceinline__ float bf_lo(unsigned w) { return __uint_as_float(w << 16); }
__device__ __forceinline__ float bf_hi(unsigned w) { return __uint_as_float(w & 0xffff0000u); }
__device__ __forceinline__ float sigmoidf_(float v) { return __builtin_amdgcn_rcpf(1.0f + __expf(-v)); }
__device__ __forceinline__ u32x4 pack8(const f32x4 a, const f32x4 b) { u32x4 w; w.x = cvt_pk_bf16(a[0], a[1]); w.y = cvt_pk_bf16(a[2], a[3]); w.z = cvt_pk_bf16(b[0], b[1]); w.w = cvt_pk_bf16(b[2], b[3]); return w; }
constexpr int SSW = 16;
constexpr float RMS_EPS = 1e-6f;
__device__ __forceinline__ void row_rs8(const float* ss, int row0, int fq, float (&rr)[8]) {
    f32x4 sv[8];
#pragma unroll
    for (int it = 0; it < 8; ++it) sv[it] = *(const f32x4*)(ss + (size_t)(row0 + (it >> 2) * HALF + (it & 3) * 16) * SSW + fq * 4);
#pragma unroll
    for (int it = 0; it < 8; ++it) { float s = (sv[it][0] + sv[it][1]) + (sv[it][2] + sv[it][3]); s += __shfl_xor(s, 16); s += __shfl_xor(s, 32); rr[it] = __builtin_amdgcn_rsqf(s * (1.0f / 1024.0f) + RMS_EPS); }
}

struct RowTab { const PG8_LAS float* tab; int pm_hi; const float* ss; };
__device__ __forceinline__ void row_rs8_tab(const RowTab& T, const Unit& u, int wr, int fr, int fq, float (&rr)[8]) {
    if ((u.pm | 8) == T.pm_hi) { const PG8_LAS float* t = T.tab + ((u.pm >> 3) & 1) * 256 + wr * 64 + fr;
#pragma unroll
        for (int it = 0; it < 8; ++it) rr[it] = t[(it >> 2) * HALF + (it & 3) * 16];
    } else row_rs8(T.ss, u.pm * BM + wr * 64 + fr, fq, rr);
}

struct EpiUp {
    static constexpr bool PERM = true, AFTER_DRAIN = false;
    bf16_t* H; int ldh; RowTab rt;
    __device__ __forceinline__ void operator()(const f32x4 (&acc)[2][2][4][2], const Unit& u, int wr, int wc, int fr_in, int fq_in) const {
        int fr = fr_in, fq = fq_in; asm volatile("" : "+v"(fr), "+v"(fq));
        const int row0 = u.pm * BM + wr * 64 + fr, hcol = u.pn * HALF + wc * 32 + 8 * fq;
        float rr[8]; row_rs8_tab(rt, u, wr, fr, fq, rr);
#pragma unroll
        for (int ai = 0; ai < 2; ++ai)
#pragma unroll
            for (int m = 0; m < 4; ++m) { int row = row0 + ai * HALF + m * 16; asm volatile("" : "+v"(row)); const float r = rr[ai * 4 + m];
                const float nrl = -1.4426950408889634f * r, r2 = r * r;
                f32x2 o[4];
#pragma unroll
                for (int n = 0; n < 2; ++n)
#pragma unroll
                    for (int hh = 0; hh < 2; ++hh) { const f32x2 g = (f32x2){acc[ai][0][m][n][2 * hh], acc[ai][0][m][n][2 * hh + 1]}, uu = (f32x2){acc[ai][1][m][n][2 * hh], acc[ai][1][m][n][2 * hh + 1]};
                        const f32x2 t = g * nrl; f32x2 d; d.x = __builtin_amdgcn_exp2f(t.x); d.y = __builtin_amdgcn_exp2f(t.y); d = d + 1.0f;
                        f32x2 iv; iv.x = __builtin_amdgcn_rcpf(d.x); iv.y = __builtin_amdgcn_rcpf(d.y);
                        o[n * 2 + hh] = (g * uu) * (iv * r2); }
                u32x4 w; w.x = cvt_pk_bf16(o[0].x, o[0].y); w.y = cvt_pk_bf16(o[1].x, o[1].y); w.z = cvt_pk_bf16(o[2].x, o[2].y); w.w = cvt_pk_bf16(o[3].x, o[3].y);
                *(u32x4*)(H + (size_t)row * ldh + hcol) = w; }
    }
};
template <int MODE> struct EpiRes {
    static constexpr bool PERM = true, AFTER_DRAIN = false;
    static constexpr int PF = (MODE == 1) ? 3 : 8;
    const bf16_t* XR; bf16_t* XW; float* ssw; float scale; const float* ssr; const bf16_t* PE; float* OUT;
    __device__ __forceinline__ void operator()(const f32x4 (&acc)[2][2][4][2], const Unit& u, int wr, int wc, int fr_in, int fq_in) const {
        int fr = fr_in, fq = fq_in; asm volatile("" : "+v"(fr), "+v"(fq));
        const int row0 = u.pm * BM + wr * 64 + fr, col0 = u.pn * BM + wc * 32 + 8 * fq;
        u32x4 xv[PF][2], pv[PF][2]; f32x4 sv[PF];
#define ER_LOAD(it, slot) do { int row_ = row0 + ((it) >> 2) * HALF + ((it) & 3) * 16; asm volatile("" : "+v"(row_)); \
            _Pragma("unroll") for (int bj = 0; bj < 2; ++bj) { const size_t off_ = (size_t)row_ * 1024 + col0 + bj * HALF; \
                xv[slot][bj] = *(const u32x4*)(XR + off_); if (MODE == 1) pv[slot][bj] = *(const u32x4*)(PE + off_); } \
            if (MODE == 1) sv[slot] = *(const f32x4*)(ssr + (size_t)row_ * SSW + fq * 4); } while (0)
#pragma unroll
        for (int it = 0; it < PF; ++it) ER_LOAD(it, it);
        asm volatile("" ::: "memory");
#pragma unroll
        for (int it = 0; it < 8; ++it) { const int ai = it >> 2, m = it & 3, slot = it % PF;
            int row = row0 + ai * HALF + m * 16; asm volatile("" : "+v"(row));
            float r = 0.f;
            if (MODE == 1) { const f32x4 v = sv[slot]; float s = (v[0] + v[1]) + (v[2] + v[3]); s += __shfl_xor(s, 16); s += __shfl_xor(s, 32); r = 1.0f / sqrtf(s * (1.0f / 1024.0f) + RMS_EPS); }
            float q = 0.f;
#pragma unroll
            for (int bj = 0; bj < 2; ++bj) { const size_t off = (size_t)row * 1024 + col0 + bj * HALF;
                const u32x4 xw = xv[slot][bj];
                f32x4 x0 = (f32x4){bf_lo(xw.x), bf_hi(xw.x), bf_lo(xw.y), bf_hi(xw.y)}, x1 = (f32x4){bf_lo(xw.z), bf_hi(xw.z), bf_lo(xw.w), bf_hi(xw.w)};
                f32x4 a0 = acc[ai][bj][m][0], a1 = acc[ai][bj][m][1];
                if (MODE == 1) { const u32x4 pw = pv[slot][bj];
                    a0[0] = sigmoidf_(a0[0] * r) * bf_lo(pw.x); a0[1] = sigmoidf_(a0[1] * r) * bf_hi(pw.x); a0[2] = sigmoidf_(a0[2] * r) * bf_lo(pw.y); a0[3] = sigmoidf_(a0[3] * r) * bf_hi(pw.y);
                    a1[0] = sigmoidf_(a1[0] * r) * bf_lo(pw.z); a1[1] = sigmoidf_(a1[1] * r) * bf_hi(pw.z); a1[2] = sigmoidf_(a1[2] * r) * bf_lo(pw.w); a1[3] = sigmoidf_(a1[3] * r) * bf_hi(pw.w);
                } else { a0 = a0 * scale; a1 = a1 * scale; }
                x0 = x0 + a0; x1 = x1 + a1;
                if (OUT) { *(f32x4*)(OUT + off) = x0; *(f32x4*)(OUT + off + 4) = x1; }
                q += (x0[0] * x0[0] + x0[1] * x0[1]) + (x0[2] * x0[2] + x0[3] * x0[3]) + (x1[0] * x1[0] + x1[1] * x1[1]) + (x1[2] * x1[2] + x1[3] * x1[3]);
                *(u32x4*)(XW + off) = pack8(x0, x1); }
            q += __shfl_xor(q, 16); q += __shfl_xor(q, 32);
            if (fq == 0) ssw[(size_t)row * SSW + u.pn * 4 + wc] = q;
            if (it + PF < 8) ER_LOAD(it + PF, slot);
            asm volatile("" ::: "memory"); }
#undef ER_LOAD
    }
};
struct EpiIn {
    static constexpr bool PERM = true, AFTER_DRAIN = false;
    bf16_t* Z; int ldz; RowTab rt; float* IF; const float* bi; const float* bf;
    __device__ __forceinline__ void operator()(const f32x4 (&acc)[2][2][4][2], const Unit& u, int wr, int wc, int fr_in, int fq_in) const {
        int fr = fr_in, fq = fq_in; asm volatile("" : "+v"(fr), "+v"(fq));
        const int row0 = u.pm * BM + wr * 64 + fr, col0 = u.pn * BM + wc * 32 + 8 * fq; const int pn = u.pn;
        float rr[8]; row_rs8_tab(rt, u, wr, fr, fq, rr);
        if (pn == 17) {
            const f32x4 bi4 = *(const f32x4*)bi, bf4 = *(const f32x4*)bf;
#pragma unroll
            for (int ai = 0; ai < 2; ++ai)
#pragma unroll
                for (int m = 0; m < 4; ++m) { int row = row0 + ai * HALF + m * 16; asm volatile("" : "+v"(row)); const float r = rr[ai * 4 + m];
                    if (wc == 0 && fq == 0) { *(f32x4*)(IF + (size_t)row * 8) = acc[ai][0][m][0] * r + bi4; *(f32x4*)(IF + (size_t)row * 8 + 4) = acc[ai][0][m][1] * r + bf4; } }
            return;
        }
        if (pn >= 9) {
            const int gc = (pn - 9) * HALF + wc * 32 + 8 * fq;
#pragma unroll
            for (int ai = 0; ai < 2; ++ai)
#pragma unroll
                for (int m = 0; m < 4; ++m) { int row = row0 + ai * HALF + m * 16; asm volatile("" : "+v"(row)); const float nrl = -1.4426950408889634f * rr[ai * 4 + m];
                    f32x4 rq[2], gq[2];
#pragma unroll
                    for (int n = 0; n < 2; ++n)
#pragma unroll
                        for (int hh = 0; hh < 2; ++hh) { f32x2 ta = (f32x2){acc[ai][0][m][n][2 * hh], acc[ai][0][m][n][2 * hh + 1]} * nrl, tb = (f32x2){acc[ai][1][m][n][2 * hh], acc[ai][1][m][n][2 * hh + 1]} * nrl;
                            ta = __builtin_elementwise_min(ta, (f32x2){60.f, 60.f}); tb = __builtin_elementwise_min(tb, (f32x2){60.f, 60.f});
                            f32x2 da, db; da.x = __builtin_amdgcn_exp2f(ta.x); da.y = __builtin_amdgcn_exp2f(ta.y); db.x = __builtin_amdgcn_exp2f(tb.x); db.y = __builtin_amdgcn_exp2f(tb.y); da = da + 1.0f; db = db + 1.0f;
                            f32x2 ia, ib; ia.x = __builtin_amdgcn_rcpf(da.x); ia.y = __builtin_amdgcn_rcpf(da.y); ib.x = __builtin_amdgcn_rcpf(db.x); ib.y = __builtin_amdgcn_rcpf(db.y);
                            const f32x2 rv = db * ia; rq[n][2 * hh] = rv.x; rq[n][2 * hh + 1] = rv.y; gq[n][2 * hh] = ib.x; gq[n][2 * hh + 1] = ib.y; }
                    *(u32x4*)(Z + (size_t)row * ldz + 2304 + gc) = pack8(rq[0], rq[1]); *(u32x4*)(Z + (size_t)row * ldz + 3328 + gc) = pack8(gq[0], gq[1]); }
            return;
        }
        const bool sig = (pn == 4) || (pn == 5);
#pragma unroll
        for (int ai = 0; ai < 2; ++ai)
#pragma unroll
            for (int m = 0; m < 4; ++m) { int row = row0 + ai * HALF + m * 16; asm volatile("" : "+v"(row)); const float r = rr[ai * 4 + m];
#pragma unroll
                for (int bj = 0; bj < 2; ++bj) { f32x4 v0, v1;
                    if (sig) { const float nrl = -1.4426950408889634f * r;
#pragma unroll
                        for (int hh = 0; hh < 2; ++hh) { f32x2 t0 = (f32x2){acc[ai][bj][m][0][2 * hh], acc[ai][bj][m][0][2 * hh + 1]} * nrl, t1 = (f32x2){acc[ai][bj][m][1][2 * hh], acc[ai][bj][m][1][2 * hh + 1]} * nrl;
                            f32x2 d0, d1; d0.x = __builtin_amdgcn_exp2f(t0.x); d0.y = __builtin_amdgcn_exp2f(t0.y); d1.x = __builtin_amdgcn_exp2f(t1.x); d1.y = __builtin_amdgcn_exp2f(t1.y); d0 = d0 + 1.0f; d1 = d1 + 1.0f;
                            v0[2 * hh] = __builtin_amdgcn_rcpf(d0.x); v0[2 * hh + 1] = __builtin_amdgcn_rcpf(d0.y); v1[2 * hh] = __builtin_amdgcn_rcpf(d1.x); v1[2 * hh + 1] = __builtin_amdgcn_rcpf(d1.y); }
                    } else { v0 = acc[ai][bj][m][0] * r; v1 = acc[ai][bj][m][1] * r; }
                    *(u32x4*)(Z + (size_t)row * ldz + col0 + bj * HALF) = pack8(v0, v1); } }
    }
};
struct EpiMixH {
    static constexpr bool PERM = true, AFTER_DRAIN = false;
    bf16_t* MIX; const bf16_t* Z; int ldz;
    template <int GOFF> __device__ __forceinline__ void scale(f32x4 (&acc)[2][2][4][2], const Unit& u, int wr, int wc, int fr_in, int fq_in, bool store) const {
        int fr = fr_in, fq = fq_in; asm volatile("" : "+v"(fr), "+v"(fq));
        const int row0 = u.pm * BM + wr * 64 + fr, col0 = u.pn * BM + wc * 32 + 8 * fq;
        u32x4 gv[8][2];
#pragma unroll
        for (int it = 0; it < 8; ++it) { int row_ = row0 + (it >> 2) * HALF + (it & 3) * 16; asm volatile("" : "+v"(row_));
#pragma unroll
            for (int bj = 0; bj < 2; ++bj) gv[it][bj] = *(const u32x4*)(Z + (size_t)row_ * ldz + GOFF + col0 + bj * HALF); }
#pragma unroll
        for (int it = 0; it < 8; ++it) { const int ai = it >> 2, m = it & 3; int row = row0 + ai * HALF + m * 16; asm volatile("" : "+v"(row));
#pragma unroll
            for (int bj = 0; bj < 2; ++bj) { const u32x4 gw = gv[it][bj];
                f32x4 v0 = acc[ai][bj][m][0], v1 = acc[ai][bj][m][1];
                v0[0] *= bf_lo(gw.x); v0[1] *= bf_hi(gw.x); v0[2] *= bf_lo(gw.y); v0[3] *= bf_hi(gw.y);
                v1[0] *= bf_lo(gw.z); v1[1] *= bf_hi(gw.z); v1[2] *= bf_lo(gw.w); v1[3] *= bf_hi(gw.w);
                if (store) *(u32x4*)(MIX + (size_t)row * 1024 + col0 + bj * HALF) = pack8(v0, v1);
                else { acc[ai][bj][m][0] = v0; acc[ai][bj][m][1] = v1; } } }
    }
    __device__ __forceinline__ void mid(f32x4 (&acc)[2][2][4][2], const Unit& u, int wr, int wc, int fr, int fq) const { scale<2304>(acc, u, wr, wc, fr, fq, false); }
    __device__ __forceinline__ void operator()(const f32x4 (&acc)[2][2][4][2], const Unit& u, int wr, int wc, int fr, int fq) const {
        scale<3328>(const_cast<f32x4 (&)[2][2][4][2]>(acc), u, wr, wc, fr, fq, true); }
};
struct EpiPlain {
    static constexpr bool PERM = true, AFTER_DRAIN = false;
    bf16_t* O; int ldc;
    __device__ __forceinline__ void operator()(const f32x4 (&acc)[2][2][4][2], const Unit& u, int wr, int wc, int fr_in, int fq_in) const {
        int fr = fr_in, fq = fq_in; asm volatile("" : "+v"(fr), "+v"(fq));
        const int row0 = u.pm * BM + wr * 64 + fr, col0 = u.pn * BM + wc * 32 + 8 * fq;
#pragma unroll
        for (int ai = 0; ai < 2; ++ai)
#pragma unroll
            for (int m = 0; m < 4; ++m) { int row = row0 + ai * HALF + m * 16; asm volatile("" : "+v"(row));
#pragma unroll
                for (int bj = 0; bj < 2; ++bj) *(u32x4*)(O + (size_t)row * ldc + col0 + bj * HALF) = pack8(acc[ai][bj][m][0], acc[ai][bj][m][1]); }
    }
};

template <class Epi, class Sched, bool ALIGN_EPI = false, bool SP2 = false, bool MIDHOOK = false>
__device__ __forceinline__ void gemm_phase(PG8_LAS unsigned char* lds, const Gemm g, const Sched& S, const Epi& E) {
    int tid_l = threadIdx.x; asm volatile("" : "+v"(tid_l));
    const int tid = tid_l, wid = __builtin_amdgcn_readfirstlane(tid >> 6), lane = tid & 63, wr = wid >> 2, wc = wid & 3, fr = lane & 15, fq = lane >> 4;
    const int K = g.K, nt = K / BK;
    unsigned voffA[2], voffB[2];
#pragma unroll
    for (int i = 0; i < 2; ++i) { int R, C; stage_rc(tid * 16 + i * 8192, R, C); const int Rb = Epi::PERM ? ((R & ~31) + perm32(R & 31)) : R;
        voffA[i] = (unsigned)(R * K + C) * 2u; voffB[i] = (unsigned)(Rb * K + C) * 2u; }
    const size_t kstep = (size_t)(BK * 2);
    const size_t hstep = (size_t)HALF * K * 2;
    const size_t tstep = 2 * hstep;
    const unsigned ldsw = (unsigned)wid * 1024u;
    const int aoff = lds_byte(wr * 64 + fr, fq * 8), boff = lds_byte(wc * 32 + fr, fq * 8);
#define PG8_SA(b, h) (((b) * 2 + (h)) * HTB)
#define PG8_SB(b, h) ((4 + (b) * 2 + (h)) * HTB)
#define PG8_STAGE(bufoff, gbase, voff) do { _Pragma("unroll") for (int _i = 0; _i < 2; ++_i) \
        __builtin_amdgcn_global_load_lds((const unsigned*)((const char*)(gbase) + (voff)[_i]), (PG8_LAS unsigned*)(lds + (bufoff) + ldsw + _i * 8192), 16, 0, 0); } while (0)
#define PG8_LDA(dst, b, h) do { _Pragma("unroll") for (int m = 0; m < 4; ++m) _Pragma("unroll") for (int k = 0; k < 2; ++k) dst[m][k] = *(const PG8_LAS bf16x8*)(lds + PG8_SA(b, h) + aoff + m * 2048 + k * 1024); } while (0)
#define PG8_LDB(dst, b, h) do { _Pragma("unroll") for (int n = 0; n < 2; ++n) _Pragma("unroll") for (int k = 0; k < 2; ++k) dst[n][k] = *(const PG8_LAS bf16x8*)(lds + PG8_SB(b, h) + boff + n * 2048 + k * 1024); } while (0)
#define PG8_MMA(ai, bj, At, Bt) do { __builtin_amdgcn_s_setprio(1); _Pragma("unroll") for (int m = 0; m < 4; ++m) _Pragma("unroll") for (int n = 0; n < 2; ++n) _Pragma("unroll") for (int k = 0; k < 2; ++k) \
        acc[ai][bj][m][n] = __builtin_amdgcn_mfma_f32_16x16x32_bf16(Bt[n][k], At[m][k], acc[ai][bj][m][n], 0, 0, 0); __builtin_amdgcn_s_setprio(0); } while (0)
#define PG8_WAIT_V(n) asm volatile("s_waitcnt vmcnt(" #n ")" ::: "memory")
#define PG8_WAIT_L(n) asm volatile("s_waitcnt lgkmcnt(" #n ")" ::: "memory")
#define PG8_BAR __builtin_amdgcn_s_barrier()
#define PG8_SCHED __builtin_amdgcn_sched_barrier(0)
    Unit cur, nxt; int ui = 0;
    if (!S.next(0, cur)) return;
    f32x4 acc[2][2][4][2];
#pragma unroll
    for (int a = 0; a < 2; ++a)
#pragma unroll
        for (int b = 0; b < 2; ++b)
#pragma unroll
            for (int m = 0; m < 4; ++m)
#pragma unroll
                for (int n = 0; n < 2; ++n) acc[a][b][m][n] = (f32x4){0.f, 0.f, 0.f, 0.f};
    bf16x8 At[4][2], B0[2][2], B1[2][2];
    const char* cA = (const char*)g.A + (size_t)cur.pm * tstep; const char* cB = (const char*)g.Bt + (size_t)cur.pn * tstep;
    S.a_ready(cur);
    if constexpr (SP2) {
        PG8_STAGE(PG8_SB(0, 0), cB, voffB); PG8_STAGE(PG8_SB(0, 1), cB + hstep, voffB); PG8_STAGE(PG8_SA(0, 0), cA, voffA); PG8_STAGE(PG8_SA(0, 1), cA + hstep, voffA);
        if (wr == 1) PG8_BAR;
        PG8_WAIT_V(2); PG8_BAR;
        PG8_STAGE(PG8_SB(1, 0), cB + kstep, voffB); PG8_STAGE(PG8_SA(1, 0), cA + kstep, voffA); PG8_STAGE(PG8_SB(1, 1), cB + hstep + kstep, voffB);
        PG8_WAIT_V(6); PG8_BAR;
    } else {
        PG8_STAGE(PG8_SB(0, 0), cB, voffB); PG8_STAGE(PG8_SA(0, 0), cA, voffA); PG8_STAGE(PG8_SB(0, 1), cB + hstep, voffB); PG8_STAGE(PG8_SA(0, 1), cA + hstep, voffA);
        if (wr == 1) PG8_BAR;
        PG8_WAIT_V(4); PG8_BAR;
        PG8_STAGE(PG8_SB(1, 0), cB + kstep, voffB); PG8_STAGE(PG8_SA(1, 0), cA + kstep, voffA); PG8_STAGE(PG8_SB(1, 1), cB + hstep + kstep, voffB);
        PG8_WAIT_V(6); PG8_BAR;
    }
    for (;;) {
        const bool has_next = S.next(ui + 1, nxt);
        const char* nA = has_next ? (const char*)g.A + (size_t)nxt.pm * tstep : cA; const char* nB = has_next ? (const char*)g.Bt + (size_t)nxt.pn * tstep : cB;
        for (int t = 0; t < nt; t += 2) {
            if constexpr (MIDHOOK) { if (t == (nt >> 1)) E.mid(acc, cur, wr, wc, fr, fq); }
            const bool last = (t == nt - 2);
            const char* a1 = cA + (size_t)(t + 1) * kstep;
            const char* a2 = last ? nA : cA + (size_t)(t + 2) * kstep; const char* b2 = last ? nB : cB + (size_t)(t + 2) * kstep;
            const char* a3 = a2 + kstep; const char* b3 = b2 + kstep;
            if (last && has_next) S.a_ready(nxt);
            if constexpr (SP2) {
            PG8_LDB(B0, 0, 0); PG8_LDB(B1, 0, 1); PG8_SCHED; PG8_LDA(At, 0, 0); PG8_STAGE(PG8_SA(1, 1), a1 + hstep, voffA);
            PG8_WAIT_V(8); PG8_WAIT_L(0); PG8_BAR; PG8_MMA(0, 0, At, B0); PG8_MMA(0, 1, At, B1); PG8_BAR; PG8_SCHED;
            PG8_LDA(At, 0, 1); PG8_STAGE(PG8_SB(0, 0), b2, voffB); PG8_STAGE(PG8_SB(0, 1), b2 + hstep, voffB); PG8_STAGE(PG8_SA(0, 0), a2, voffA);
            PG8_WAIT_V(8); PG8_WAIT_L(0); PG8_BAR; PG8_MMA(1, 0, At, B0); PG8_MMA(1, 1, At, B1); PG8_BAR; PG8_SCHED;
            PG8_LDB(B0, 1, 0); PG8_LDB(B1, 1, 1); PG8_SCHED; PG8_LDA(At, 1, 0); PG8_STAGE(PG8_SA(0, 1), a2 + hstep, voffA);
            PG8_WAIT_V(8); PG8_WAIT_L(0); PG8_BAR; PG8_MMA(0, 0, At, B0); PG8_MMA(0, 1, At, B1); PG8_BAR; PG8_SCHED;
            PG8_LDA(At, 1, 1); PG8_STAGE(PG8_SB(1, 0), b3, voffB); PG8_STAGE(PG8_SB(1, 1), b3 + hstep, voffB); PG8_STAGE(PG8_SA(1, 0), a3, voffA);
            PG8_WAIT_V(8); PG8_WAIT_L(0); PG8_BAR; PG8_MMA(1, 0, At, B0); PG8_MMA(1, 1, At, B1); PG8_BAR; PG8_SCHED;
            } else {
            PG8_LDB(B0, 0, 0); PG8_SCHED; PG8_LDA(At, 0, 0); PG8_STAGE(PG8_SA(1, 1), a1 + hstep, voffA);
            PG8_WAIT_L(8); PG8_BAR; PG8_WAIT_L(0); PG8_MMA(0, 0, At, B0); PG8_BAR; PG8_SCHED;
            PG8_LDB(B1, 0, 1); PG8_STAGE(PG8_SB(0, 0), b2, voffB);
            PG8_BAR; PG8_WAIT_L(0); PG8_MMA(0, 1, At, B1); PG8_BAR;
            PG8_LDA(At, 0, 1); PG8_STAGE(PG8_SA(0, 0), a2, voffA);
            PG8_BAR; PG8_WAIT_L(0); PG8_MMA(1, 0, At, B0); PG8_BAR; PG8_SCHED;
            PG8_STAGE(PG8_SB(0, 1), b2 + hstep, voffB);
            PG8_WAIT_V(6); PG8_BAR; PG8_MMA(1, 1, At, B1); PG8_BAR;
            PG8_LDB(B0, 1, 0); PG8_SCHED; PG8_LDA(At, 1, 0); PG8_STAGE(PG8_SA(0, 1), a2 + hstep, voffA);
            PG8_WAIT_L(8); PG8_BAR; PG8_WAIT_L(0); PG8_MMA(0, 0, At, B0); PG8_BAR; PG8_SCHED;
            PG8_LDB(B1, 1, 1); PG8_STAGE(PG8_SB(1, 0), b3, voffB);
            PG8_BAR; PG8_WAIT_L(0); PG8_MMA(0, 1, At, B1); PG8_BAR;
            PG8_LDA(At, 1, 1); PG8_STAGE(PG8_SA(1, 0), a3, voffA);
            PG8_BAR; PG8_WAIT_L(0); PG8_MMA(1, 0, At, B0); PG8_BAR; PG8_SCHED;
            PG8_STAGE(PG8_SB(1, 1), b3 + hstep, voffB);
            PG8_WAIT_V(6); PG8_BAR; PG8_MMA(1, 1, At, B1); PG8_BAR;
            }
        }
        if constexpr (ALIGN_EPI) { if (wr == 0) PG8_BAR; }
        if constexpr (!Epi::AFTER_DRAIN) { E(acc, cur, wr, wc, fr, fq); S.done(cur); }
        if (!has_next) break;
#pragma unroll
        for (int a = 0; a < 2; ++a)
#pragma unroll
            for (int b = 0; b < 2; ++b)
#pragma unroll
                for (int m = 0; m < 4; ++m)
#pragma unroll
                    for (int n = 0; n < 2; ++n) acc[a][b][m][n] = (f32x4){0.f, 0.f, 0.f, 0.f};
        cur = nxt; cA = nA; cB = nB; ++ui;
        if constexpr (ALIGN_EPI) { if (wr == 1) PG8_BAR; }
    }
    PG8_WAIT_V(0);
    if constexpr (!ALIGN_EPI) { if (wr == 0) PG8_BAR; }
    PG8_BAR;
    if constexpr (Epi::AFTER_DRAIN) { E.fused(acc, cur, wr, wc, fr, fq, lds, wid, lane); S.done(cur); }
#undef PG8_SA
#undef PG8_SB
#undef PG8_STAGE
#undef PG8_LDA
#undef PG8_LDB
#undef PG8_MMA
#undef PG8_WAIT_V
#undef PG8_WAIT_L
#undef PG8_BAR
#undef PG8_SCHED
}
}
#define GAS __attribute__((address_space(1)))
#define LAS __attribute__((address_space(3)))
typedef unsigned short bf16;
typedef unsigned v4u __attribute__((ext_vector_type(4)));
typedef float f32x4 __attribute__((ext_vector_type(4)));
typedef short bf16x8 __attribute__((ext_vector_type(8)));
typedef GAS unsigned gu32;
typedef GAS unsigned long long gu64;
#define RLX_AGENT __ATOMIC_RELAXED, __HIP_MEMORY_SCOPE_AGENT
#define LDS_WAIT() asm volatile("s_waitcnt lgkmcnt(0)" ::: "memory")
#define VM_WAIT() asm volatile("s_waitcnt vmcnt(0)" ::: "memory")
__device__ __forceinline__ unsigned long long rt() { return __builtin_amdgcn_s_memrealtime(); }
__device__ __forceinline__ unsigned f2bf(float f) { unsigned u = __builtin_bit_cast(unsigned, f); return (u + 0x7fffu + ((u >> 16) & 1u)) >> 16; }
__device__ __forceinline__ unsigned pk2(float lo, float hi) { return f2bf(lo) | (f2bf(hi) << 16); }

#define XB_TMO      128
#define XB_XCNT(j)  (256  + 64 * (j))
#define XB_XSUB(j)  (1280 + 64 * (j))
#define XB_XGEN(j)  (2304 + 64 * (j))
#define XB_TOP      3328
#define XB_TOPGEN   3392
#define XCD_BAR_WORDS 3456
#define XB_SPIN_CAP (1u << 18)

__device__ __forceinline__ unsigned xb_ld(unsigned* p)              { return __hip_atomic_load(p, __ATOMIC_RELAXED, __HIP_MEMORY_SCOPE_AGENT); }
__device__ __forceinline__ unsigned xb_add(unsigned* p, unsigned v) { return __hip_atomic_fetch_add(p, v, __ATOMIC_RELAXED, __HIP_MEMORY_SCOPE_AGENT); }
__device__ __forceinline__ unsigned xb_xcc_id() { return (unsigned)__builtin_amdgcn_s_getreg((3 << 11) | 20) & 0xFu; }
#define XB_SPIN(cond, bar) do { unsigned _sp = 0; while (cond) { __builtin_amdgcn_s_sleep(1); \
    if ((++_sp & 255u) == 0u) { if (xb_ld(&(bar)[XB_TMO])) break; if (_sp > XB_SPIN_CAP) { atomicAdd(&(bar)[XB_TMO], 1u); break; } } } } while (0)

struct XcdBarrier {
    unsigned* bar; unsigned x;
    volatile LAS unsigned* st;
};

__device__ __forceinline__ XcdBarrier xcd_barrier_post(unsigned* bar, volatile LAS unsigned* st) {
    XcdBarrier b; b.bar = bar; b.x = xb_xcc_id(); b.st = st;
    if (threadIdx.x == 0) (void)xb_add(&bar[XB_XCNT(b.x)], 1u);
    return b;
}
__device__ __forceinline__ void xcd_barrier_complete(unsigned* bar, unsigned x, unsigned& nloc, unsigned& nx) {
    const unsigned G = gridDim.x * gridDim.y * gridDim.z;
    unsigned sum, cnt, mine, sp = 0u;
    for (;;) {
        sum = 0u; cnt = 0u; mine = 0u;
#pragma unroll
        for (unsigned j = 0; j < 16; ++j) { const unsigned c = xb_ld(&bar[XB_XCNT(j)]); sum += c; cnt += (c > 0u) ? 1u : 0u; mine = (j == x) ? c : mine; }
        if (sum == G) break;
        __builtin_amdgcn_s_sleep(1);
        if ((++sp & 255u) == 0u) { if (xb_ld(&bar[XB_TMO])) break; if (sp > XB_SPIN_CAP) { atomicAdd(&bar[XB_TMO], 1u); break; } }
    }
    nloc = mine > 0u ? mine : 1u; nx = cnt > 0u ? cnt : 1u;
}

__device__ __forceinline__ void xcd_barrier(const XcdBarrier& b) {
    asm volatile("s_waitcnt vmcnt(0)" ::: "memory");
    __syncthreads();
    if (threadIdx.x == 0) {
        unsigned* bar = b.bar;
        __builtin_amdgcn_s_waitcnt(0);
        unsigned nloc = b.st[0], nx = b.st[1];
        if (nloc == 0u) { unsigned xo = b.x; asm volatile("" : "+s"(xo)); xcd_barrier_complete(bar, xo, nloc, nx); b.st[0] = nloc; b.st[1] = nx; }
        const unsigned old = xb_add(&bar[XB_XSUB(b.x)], 1u);
        const unsigned gen = old / nloc;
        if (old + 1u == (gen + 1u) * nloc) {
            __builtin_amdgcn_fence(__ATOMIC_RELEASE, "agent");
            asm volatile("s_waitcnt vmcnt(0)" ::: "memory");
            const unsigned og = xb_add(&bar[XB_TOP], 1u);
            const unsigned tg = og / nx;
            if (og + 1u == (tg + 1u) * nx) xb_add(&bar[XB_TOPGEN], 1u);
            else XB_SPIN(xb_ld(&bar[XB_TOPGEN]) == tg, bar);
            __builtin_amdgcn_fence(__ATOMIC_ACQUIRE, "agent");
            xb_add(&bar[XB_XGEN(b.x)], 1u);
            asm volatile("s_waitcnt vmcnt(0)" ::: "memory");
        } else {
            XB_SPIN(xb_ld(&bar[XB_XGEN(b.x)]) == gen, bar);
            __builtin_amdgcn_fence(__ATOMIC_ACQUIRE, "agent");
            asm volatile("s_waitcnt vmcnt(0)" ::: "memory");
        }
    }
    __syncthreads();
}

constexpr int NWAVES = 8;
constexpr int NBATCH = 8, SEQ = 4096, DM = 1024, DEPTH = 4, M = NBATCH * SEQ, PD = 256, FF = 2816, NUP = 2 * FF, DIN = 4360, NIN = 4608;
constexpr int NUNIT_ML = NBATCH * 64 * 4;
constexpr int NUNIT_SW = NBATCH * 32 * 2;
constexpr float EPSF = 1e-6f;
constexpr int ZC_MQ = 0, ZC_MK = 256, ZC_MV = 512, ZC_MO = 1024, ZC_SQ = 1536, ZC_SK = 2048, ZC_SV = 2176, ZC_GA = 2304, ZC_GB = 3328, ZC_IF = 4352;

constexpr size_t MiB = 1u << 20;
constexpr size_t WS_CTL = 0, CTL_REGION_BYTES = 1 * MiB;
constexpr size_t WS_SSA = 1 * MiB, WS_SSB = 3 * MiB;
constexpr size_t WS_IF = 5 * MiB;
constexpr size_t WS_NST = 6 * MiB;
constexpr size_t WS_GM = 6 * MiB + 512 * 1024;
constexpr size_t WS_NP = 6 * MiB + 576 * 1024;
constexpr size_t WS_CPT = 202 * MiB;
constexpr size_t WS_BT = 7 * MiB + 512 * 1024;
constexpr size_t WS_W = 8 * MiB;
constexpr size_t WS_PB = 58 * MiB;
constexpr size_t WS_XB0 = 74 * MiB;
constexpr size_t WS_HA = 138 * MiB;
constexpr size_t WS_PE = 138 * MiB;
constexpr size_t WS_MIX = 202 * MiB;
constexpr size_t WS_CST = 266 * MiB;
constexpr size_t WS_Z = 330 * MiB;
constexpr size_t WS_H = WS_Z;
constexpr size_t WS_XB1 = WS_Z + 192 * MiB;
constexpr size_t WS_END = 618 * MiB;
constexpr size_t WO_UP1 = 0, WO_DN1 = WO_UP1 + (size_t)NUP * DM, WO_IN = WO_DN1 + (size_t)DM * FF, WO_A = WO_IN + (size_t)NIN * DM, WO_B = WO_A + (size_t)DM * 512,
                 WO_OUT = WO_B + (size_t)DM * 512, WO_UP2 = WO_OUT + (size_t)DM * DM, WO_DN2 = WO_UP2 + (size_t)NUP * DM, WO_PG = WO_DN2 + (size_t)DM * FF, WO_PLE = WO_PG + (size_t)DM * DM,
                 WO_END = WO_PLE + (size_t)DM * PD;
static_assert(WO_END * 2 <= 50 * MiB, "weights fit");
static_assert(WS_Z + (size_t)M * NIN * 2 <= WS_END && WS_H + (size_t)M * FF * 2 <= WS_XB1 && WS_XB1 + (size_t)M * DM * 2 <= WS_END, "ws map");
constexpr int CW_BAR = 4096;
constexpr int NPHASE = 12 * DEPTH;
#ifndef MK_N_LAUNCHES
#define MK_N_LAUNCHES 1
#endif
constexpr size_t CTL_ZERO_BYTES = (((size_t)(CW_BAR + (MK_N_LAUNCHES) * XCD_BAR_WORDS) * 4 + 4095) / 4096) * 4096;
static_assert(CTL_ZERO_BYTES <= CTL_REGION_BYTES, "barrier words inside the control region");

constexpr int RING_OFF = 0, RING_BYTES = 131072;
constexpr int LDSCTL_OFF = RING_BYTES, MISC_OFF = LDSCTL_OFF + 320;
constexpr int LDS_BYTES = 147456;
constexpr int RTAB_OFF = LDSCTL_OFF + 1024;

typedef unsigned u32x4 __attribute__((ext_vector_type(4)));
typedef short bf16x8_t __attribute__((ext_vector_type(8)));
typedef unsigned u32x2 __attribute__((ext_vector_type(2)));
__device__ const unsigned char T5_BUCKET[128] = {0,1,2,3,4,5,6,7,8,9,10,11,12,13,14,15,16,16,16,17,17,18,18,18,19,19,19,20,20,20,20,21,21,21,21,22,22,22,22,22,23,23,23,23,23,23,24,24,24,24,24,24,25,25,25,25,25,25,25,26,26,26,26,26,26,26,26,27,27,27,27,27,27,27,27,27,27,28,28,28,28,28,28,28,28,28,28,29,29,29,29,29,29,29,29,29,29,29,29,30,30,30,30,30,30,30,30,30,30,30,30,30,30,31,31,31,31,31,31,31,31,31,31,31,31,31,31,31};

__device__ __forceinline__ float bflo(unsigned w) { return __uint_as_float(w << 16); }
__device__ __forceinline__ float bfhi(unsigned w) { return __uint_as_float(w & 0xffff0000u); }
__device__ __forceinline__ void unpack8(const u32x4 w, float (&f)[8]) { f[0] = bflo(w.x); f[1] = bfhi(w.x); f[2] = bflo(w.y); f[3] = bfhi(w.y); f[4] = bflo(w.z); f[5] = bfhi(w.z); f[6] = bflo(w.w); f[7] = bfhi(w.w); }
__device__ __forceinline__ u32x4 pack8f(const float (&f)[8]) { u32x4 w; w.x = pk2(f[0], f[1]); w.y = pk2(f[2], f[3]); w.z = pk2(f[4], f[5]); w.w = pk2(f[6], f[7]); return w; }
__device__ __forceinline__ float wave_sum(float v) {
#pragma unroll
    for (int o = 1; o < 64; o <<= 1) v += __shfl_xor(v, o);
    return v;
}
__device__ __forceinline__ float wave_max(float v) {
#pragma unroll
    for (int o = 1; o < 64; o <<= 1) v = fmaxf(v, __shfl_xor(v, o));
    return v;
}
__device__ __forceinline__ float wave_incl_sum(float v, int lane) {
#pragma unroll
    for (int o = 1; o < 64; o <<= 1) { const float t = __shfl_up(v, o); if (lane >= o) v += t; }
    return v;
}
__device__ __forceinline__ float wave_incl_max(float v, int lane) {
#pragma unroll
    for (int o = 1; o < 64; o <<= 1) { const float t = __shfl_up(v, o); if (lane >= o) v = fmaxf(v, t); }
    return v;
}
__device__ __forceinline__ float logsigmoidf_(float x) { return fminf(x, 0.f) - log1pf(expf(-fabsf(x))); }

template <int MAP> __device__ __forceinline__ int cvt_map(int n, int N) {
    if (n >= N) return -1;
    if (MAP == 1) { return n < FF ? ((n >> 7) * 256 + (n & 127)) : (((n - FF) >> 7) * 256 + 128 + ((n - FF) & 127)); }
    if (MAP == 2) { if (n < 1536) return n; if (n < 1544) return ZC_IF + n - 1536; if (n < 2312) return n - 8;
        if (n < 3336) { const int j = n - 2312; return ZC_GA + (j >> 7) * 256 + (j & 127); }
        const int j = n - 3336; return ZC_GA + (j >> 7) * 256 + 128 + (j & 127); }
    return n;
}
template <int MAP> __device__ __forceinline__ void cvt_item(const float* W, int K, int N, const float* gain, bf16* WT, LAS float* scr, int item, int lane, int ldw = 0, int koff = 0) {
    if (ldw == 0) ldw = K;
    const int nblk = (N + 31) / 32, kb = item / nblk, nb = item % nblk, k0 = 64 * kb, n0 = 32 * nb;
    const int nn = n0 + (lane & 31); const bool nv = nn < N;
    float wreg[32];
#pragma unroll
    for (int i = 0; i < 32; ++i) { const int kk = 2 * i + (lane >> 5); wreg[i] = nv ? W[(size_t)(k0 + kk) * N + nn] : 0.f; }
#pragma unroll
    for (int i = 0; i < 32; ++i) { const int kk = 2 * i + (lane >> 5); float w = wreg[i]; if (gain) w *= gain[k0 + kk]; scr[kk * 33 + (lane & 31)] = w; }
    LDS_WAIT(); asm volatile("" ::: "memory");
    const int c = lane & 7;
#pragma unroll
    for (int j = 0; j < 4; ++j) { const int n = (lane >> 3) + 8 * j; const LAS float* s = scr + (8 * c) * 33 + n;
        v4u o; o.x = pk2(s[0 * 33], s[1 * 33]); o.y = pk2(s[2 * 33], s[3 * 33]); o.z = pk2(s[4 * 33], s[5 * 33]); o.w = pk2(s[6 * 33], s[7 * 33]);
        const int dr = cvt_map<MAP>(n0 + n, N);
        if (dr >= 0) *(GAS v4u*)(WT + (size_t)dr * ldw + koff + k0 + 8 * c) = o; }
    LDS_WAIT(); asm volatile("" ::: "memory");
}

struct Args { const float* in[23]; float* out; unsigned char* ws; int ph_lo, ph_hi, li, pad; };
typedef const __attribute__((address_space(4))) Args* KArgs;
enum { I_X = 0, I_P, I_FFN1_NORM, I_FFN1_WI, I_FFN1_WO, I_MIX_NORM, I_W_IN, I_B_I, I_B_F, I_ML_NORM, I_Q_NORM, I_K_NORM, I_SINKS, I_REL_BIAS, I_W_A, I_W_B, I_W_OUT, I_FFN2_NORM, I_FFN2_WI, I_FFN2_WO, I_PLE_NORM, I_W_PG, I_W_PLE };
#define PHASE_ENTRY(ka) KArgs A = (ka); asm volatile("" : "+s"(A)); int tid = threadIdx.x; asm volatile("" : "+v"(tid)); unsigned char* const ws = A->ws; (void)ws; (void)tid

__device__ __forceinline__ void convert_part(KArgs ka, LAS unsigned char* lds, int lb, int la, int brank, int nblocks, int w0, int w1) {
    PHASE_ENTRY(ka);
    const int lane = tid & 63, wave = tid >> 6;
    LAS float* scr = (LAS float*)(lds + wave * 16384);
    bf16* Wb = (bf16*)(ws + WS_W);
    constexpr int I_UP = (DM / 64) * (NUP / 32), I_DN = (FF / 64) * (DM / 32), I_IN = (DM / 64) * ((DIN + 31) / 32), I_A = (512 / 64) * (DM / 32), I_OUT = (DM / 64) * (DM / 32), I_PLE = (PD / 64) * (DM / 32);
    constexpr int NB_ITEMS = I_UP + I_DN + 2 * I_A + 2 * I_OUT + I_PLE, NA_ITEMS = I_UP + I_DN + I_IN;
    const int nB = (lb >= 0) ? NB_ITEMS : 0, nA = (la >= 0) ? NA_ITEMS : 0, NI = nB + nA;
    const int i0 = (int)((long)NI * w0 / 256), i1 = (int)((long)NI * w1 / 256);
    for (int it = i0 + brank * NWAVES + wave; it < i1; it += nblocks * NWAVES) {
        int r = it;
        if (r < nB) { const int l = lb;
            if (r < I_UP) { cvt_item<1>(A->in[I_FFN2_WI] + (size_t)l * DM * NUP, DM, NUP, A->in[I_FFN2_NORM] + l * DM, Wb + WO_UP2, scr, r, lane); continue; } r -= I_UP;
            if (r < I_DN) { cvt_item<0>(A->in[I_FFN2_WO] + (size_t)l * FF * DM, FF, DM, nullptr, Wb + WO_DN2, scr, r, lane); continue; } r -= I_DN;
            if (r < I_A) { cvt_item<0>(A->in[I_W_A] + (size_t)l * 512 * DM, 512, DM, nullptr, Wb + WO_A, scr, r, lane, DM, 0); continue; } r -= I_A;
            if (r < I_A) { cvt_item<0>(A->in[I_W_B] + (size_t)l * 512 * DM, 512, DM, nullptr, Wb + WO_A, scr, r, lane, DM, 512); continue; } r -= I_A;
            if (r < I_OUT) { cvt_item<0>(A->in[I_W_OUT] + (size_t)l * DM * DM, DM, DM, nullptr, Wb + WO_OUT, scr, r, lane); continue; } r -= I_OUT;
            if (r < I_OUT) { cvt_item<0>(A->in[I_W_PG] + (size_t)l * DM * DM, DM, DM, A->in[I_PLE_NORM] + l * DM, Wb + WO_PG, scr, r, lane); continue; } r -= I_OUT;
            cvt_item<0>(A->in[I_W_PLE] + (size_t)l * PD * DM, PD, DM, nullptr, Wb + WO_PLE, scr, r, lane); continue; }
        r -= nB; { const int l = la;
            if (r < I_UP) { cvt_item<1>(A->in[I_FFN1_WI] + (size_t)l * DM * NUP, DM, NUP, A->in[I_FFN1_NORM] + l * DM, Wb + WO_UP1, scr, r, lane); continue; } r -= I_UP;
            if (r < I_DN) { cvt_item<0>(A->in[I_FFN1_WO] + (size_t)l * FF * DM, FF, DM, nullptr, Wb + WO_DN1, scr, r, lane); continue; } r -= I_DN;
            cvt_item<2>(A->in[I_W_IN] + (size_t)l * DM * DIN, DM, DIN, A->in[I_MIX_NORM] + l * DM, Wb + WO_IN, scr, r, lane); }
    }
    const int gt = brank * 512 + tid, ngt = nblocks * 512;
    if (la >= 0) {
        bf16* wi = Wb + WO_IN + (size_t)(ZC_IF + 8) * DM; const int nz = (NIN - ZC_IF - 8) * DM / 8;
        const int c0 = (int)((long)nz * w0 / 256), c1 = (int)((long)nz * w1 / 256);
        for (int i = c0 + gt; i < c1; i += ngt) *(GAS v4u*)(wi + (size_t)i * 8) = (v4u){0u, 0u, 0u, 0u};
    }
    if (lb >= 0) {
        const float* pl = A->in[I_P] + (size_t)lb * M * PD; bf16* pb = (bf16*)(ws + WS_PB); const int nch = M * PD / 8;
        const int c0 = (int)((long)nch * w0 / 256), c1 = (int)((long)nch * w1 / 256);
        for (int i = c0 + gt; i < c1; i += ngt) { const f32x4 a = *(const GAS f32x4*)(pl + (size_t)i * 8), b = *(const GAS f32x4*)(pl + (size_t)i * 8 + 4);
            v4u o; o.x = pk2(a.x, a.y); o.y = pk2(a.z, a.w); o.z = pk2(b.x, b.y); o.w = pk2(b.z, b.w); *(GAS v4u*)(pb + (size_t)i * 8) = o; }
    }
}
__device__ __forceinline__ void phase_prologue(KArgs ka, LAS unsigned char* lds, int G) {
    convert_part(ka, lds, -1, 0, (int)blockIdx.x, G, 0, 256);
    PHASE_ENTRY(ka);
    const int lane = tid & 63, wave = tid >> 6;
    const int gw = blockIdx.x * NWAVES + wave, NGW = G * NWAVES;
    {
        bf16* xb = (bf16*)(ws + WS_XB0); float* ssa = (float*)(ws + WS_SSA);
        for (int m = gw; m < M; m += NGW) {
            const GAS f32x4* xr = (const GAS f32x4*)(A->in[I_X] + (size_t)m * DM) + lane;
            GAS unsigned long long* o8 = (GAS unsigned long long*)(xb + (size_t)m * DM) + lane;
            float s = 0.f;
#pragma unroll
            for (int j = 0; j < 4; ++j) { const f32x4 v = xr[64 * j]; s += (v.x * v.x + v.y * v.y) + (v.z * v.z + v.w * v.w);
                o8[64 * j] = (unsigned long long)pk2(v.x, v.y) | ((unsigned long long)pk2(v.z, v.w) << 32); }
            s = wave_sum(s);
            if (lane < 16) ssa[(size_t)m * 16 + lane] = (lane == 0) ? s : 0.f;
        }
        if (blockIdx.x == 0) { float* bt = (float*)(ws + WS_BT);
            for (int i = tid; i < 8 * 128; i += 512) { const int hq = i >> 7, dist = i & 127; bt[i] = A->in[I_REL_BIAS][(int)T5_BUCKET[dist] * 8 + hq]; } }
    }
}

__device__ __forceinline__ void mlstm_scan2(LAS unsigned char* lds, const int tid, const bf16* CLT, const float* Nst, float* GM, bf16* CPT, float* NP, int G) {
    LAS float* gl = (LAS float*)lds; LAS float* ml = gl + 64; LAS float* so = ml + 64; LAS float* sn = so + 64;
    for (int wi = blockIdx.x; wi < 128; wi += G) {
        const int bh = wi >> 2, qt = wi & 3, b = bh >> 2, h = bh & 3;
        if (tid < 64) { const size_t uid = (size_t)((b * 64 + tid) * 4 + h); gl[tid] = GM[uid * 4]; ml[tid] = GM[uid * 4 + 1]; }
        __syncthreads();
        if (tid == 0) { float mcur = 0.f;
            for (int c = 0; c < 64; ++c) { const float g = gl[c], mc = ml[c]; const float mn = fmaxf(g + mcur, mc);
                so[c] = expf(g + mcur - mn); sn[c] = expf(mc - mn); if (qt == 0) GM[(size_t)((b * 64 + c) * 4 + h) * 4 + 2] = mcur; mcur = mn; } }
        __syncthreads();
        const int e = 32 * qt + (tid >> 4), d0 = (tid & 15) * 4;
        float C0 = 0.f, C1 = 0.f, C2 = 0.f, C3 = 0.f;
        for (int c0 = 0; c0 < 64; c0 += 16) {
            u32x2 cv[16];
#pragma unroll
            for (int j = 0; j < 16; ++j) cv[j] = *(const u32x2*)(CLT + (size_t)((b * 64 + c0 + j) * 4 + h) * 8192 + (size_t)e * 64 + d0);
#pragma unroll
            for (int j = 0; j < 16; ++j) { const size_t uid = (size_t)((b * 64 + c0 + j) * 4 + h); const float s_o = so[c0 + j], s_n = sn[c0 + j];
                u32x2 w; w.x = pk2(C0, C1); w.y = pk2(C2, C3); *(u32x2*)(CPT + uid * 8192 + (size_t)e * 64 + d0) = w;
                C0 = s_o * C0 + s_n * bflo(cv[j].x); C1 = s_o * C1 + s_n * bfhi(cv[j].x); C2 = s_o * C2 + s_n * bflo(cv[j].y); C3 = s_o * C3 + s_n * bfhi(cv[j].y); }
        }
        if (qt == 0 && tid < 64) { float n = 0.f;
            for (int c0 = 0; c0 < 64; c0 += 8) { float nv[8];
#pragma unroll
                for (int j = 0; j < 8; ++j) nv[j] = Nst[(size_t)((b * 64 + c0 + j) * 4 + h) * 64 + tid];
#pragma unroll
                for (int j = 0; j < 8; ++j) { NP[(size_t)((b * 64 + c0 + j) * 4 + h) * 64 + tid] = n; n = so[c0 + j] * n + sn[c0 + j] * nv[j]; } } }
        __syncthreads();
    }
}

__device__ __forceinline__ void swa_unit_mfma(LAS unsigned char* lds, const int tid, int uid, const bf16* Z, const float* qgain, const float* kgain, const float* sinks, const float* bt, bf16* HB) {
    const int lane = tid & 63, wave = tid >> 6, c_in = lane & 15, g4_in = lane >> 4;
    const int kvh = uid & 1, nb = (uid >> 1) & 31, b = uid >> 6;
    LAS unsigned char* Ks = lds; LAS unsigned short* Vt = (LAS unsigned short*)(lds + 256 * 144); LAS float* bl = (LAS float*)(lds + 256 * 144 + 64 * 264 * 2);
#pragma unroll
    for (int i = 0; i < 4; ++i) { const int cc = tid + 512 * i, j = cc >> 3, ch = cc & 7; const bool ok = (nb > 0) || (j >= 128);
        const size_t krow = (size_t)b * SEQ + (size_t)(nb * 128 + j) - 128;
        u32x4 kq = (u32x4){0u, 0u, 0u, 0u}, vq = (u32x4){0u, 0u, 0u, 0u};
        const int jv = lane + 64 * i; const bool okv = (nb > 0) || (jv >= 128);
        if (ok) kq = *(const u32x4*)(Z + krow * NIN + ZC_SK + kvh * 64 + ch * 8);
        if (okv) vq = *(const u32x4*)(Z + ((size_t)b * SEQ + (size_t)(nb * 128 + jv) - 128) * NIN + ZC_SV + kvh * 64 + wave * 8);
        float kf[8]; unpack8(kq, kf); float ssq = 0.f;
#pragma unroll
        for (int e = 0; e < 8; ++e) ssq += kf[e] * kf[e];
        ssq += __shfl_xor(ssq, 1); ssq += __shfl_xor(ssq, 2); ssq += __shfl_xor(ssq, 4);
        const float rn = 1.0f / sqrtf(ssq * (1.0f / 64.0f) + EPSF);
#pragma unroll
        for (int e = 0; e < 8; ++e) kf[e] = kf[e] * rn * kgain[ch * 8 + e];
        *(LAS u32x4*)(Ks + j * 144 + ch * 16) = pack8f(kf);
        LAS unsigned short* vp = Vt + (wave * 8) * 264 + jv;
        vp[0 * 264] = (unsigned short)(vq.x & 0xffffu); vp[1 * 264] = (unsigned short)(vq.x >> 16); vp[2 * 264] = (unsigned short)(vq.y & 0xffffu); vp[3 * 264] = (unsigned short)(vq.y >> 16);
        vp[4 * 264] = (unsigned short)(vq.z & 0xffffu); vp[5 * 264] = (unsigned short)(vq.z >> 16); vp[6 * 264] = (unsigned short)(vq.w & 0xffffu); vp[7 * 264] = (unsigned short)(vq.w >> 16); }
    bl[tid] = bt[(kvh * 4 + (tid >> 7)) * 128 + (tid & 127)];
    __syncthreads();
    const int qg = wave;
    u32x4 qn0, qn1;
    { const bf16* qp = Z + ((size_t)b * SEQ + nb * 128 + qg * 16 + c_in) * NIN + ZC_SQ + (kvh * 4) * 64 + 8 * g4_in; qn0 = *(const u32x4*)qp; qn1 = *(const u32x4*)(qp + 32); }
    for (int g = 0; g < 4; ++g) {
        int c = c_in, g4 = g4_in; asm volatile("" : "+v"(c), "+v"(g4));
        const int hq = kvh * 4 + g, qi = qg * 16 + c; const size_t row = (size_t)b * SEQ + nb * 128 + qi;
        bf16x8_t qf[2];
        {
            float f0[8], f1[8];
            unpack8(qn0, f0); unpack8(qn1, f1);
            if (g + 1 < 4) { const bf16* qp = Z + row * NIN + ZC_SQ + (hq + 1) * 64 + 8 * g4; qn0 = *(const u32x4*)qp; qn1 = *(const u32x4*)(qp + 32); }
            float ssq = 0.f;
#pragma unroll
            for (int e = 0; e < 8; ++e) ssq += f0[e] * f0[e] + f1[e] * f1[e];
            ssq += __shfl_xor(ssq, 16); ssq += __shfl_xor(ssq, 32);
            const float rn = 0.125f / sqrtf(ssq * (1.0f / 64.0f) + EPSF);
#pragma unroll
            for (int e = 0; e < 8; ++e) { f0[e] = f0[e] * rn * qgain[8 * g4 + e]; f1[e] = f1[e] * rn * qgain[32 + 8 * g4 + e]; }
            qf[0] = __builtin_bit_cast(bf16x8_t, pack8f(f0)); qf[1] = __builtin_bit_cast(bf16x8_t, pack8f(f1));
        }
        f32x4 sc[9];
        const float sink = sinks[hq]; float mx = sink;
        const LAS float* blg = bl + g * 128;
#pragma unroll
        for (int tt = 0; tt < 9; ++tt) { const int T = qg + tt;
            const LAS unsigned char* kp = Ks + (16 * T + c) * 144 + 16 * g4;
            const bf16x8_t ka0 = *(const LAS bf16x8_t*)kp, ka1 = *(const LAS bf16x8_t*)(kp + 64);
            f32x4 a = (f32x4){0.f, 0.f, 0.f, 0.f};
            a = __builtin_amdgcn_mfma_f32_16x16x32_bf16(ka0, qf[0], a, 0, 0, 0);
            a = __builtin_amdgcn_mfma_f32_16x16x32_bf16(ka1, qf[1], a, 0, 0, 0);
            const bool tile_ok = (nb > 0) || (T >= 8);
#pragma unroll
            for (int r = 0; r < 4; ++r) { const int dist = 128 + c - 16 * tt - 4 * g4 - r;
                bool valid = tile_ok; if (tt == 0) valid = valid && (dist < 128); if (tt == 8) valid = valid && (dist >= 0);
                const float s = a[r] + blg[dist & 127];
                a[r] = valid ? s : -INFINITY; mx = fmaxf(mx, a[r]); }
            sc[tt] = a; }
        mx = fmaxf(mx, __shfl_xor(mx, 16)); mx = fmaxf(mx, __shfl_xor(mx, 32));
        float ls = 0.f;
#pragma unroll
        for (int tt = 0; tt < 9; ++tt)
#pragma unroll
            for (int r = 0; r < 4; ++r) { const float p = __expf(sc[tt][r] - mx); sc[tt][r] = p; ls += p; }
        ls += __shfl_xor(ls, 16); ls += __shfl_xor(ls, 32);
        const float il = 1.0f / (ls + __expf(sink - mx));
        f32x4 o[4];
#pragma unroll
        for (int db = 0; db < 4; ++db) o[db] = (f32x4){0.f, 0.f, 0.f, 0.f};
#pragma unroll
        for (int pr = 0; pr < 5; ++pr) { const int t0 = 2 * pr, t1 = (pr < 4) ? 2 * pr + 1 : 8;
            u32x4 pw; pw.x = pk2(sc[t0][0], sc[t0][1]); pw.y = pk2(sc[t0][2], sc[t0][3]);
            if (pr < 4) { pw.z = pk2(sc[t1][0], sc[t1][1]); pw.w = pk2(sc[t1][2], sc[t1][3]); } else { pw.z = 0u; pw.w = 0u; }
            const bf16x8_t pf = __builtin_bit_cast(bf16x8_t, pw);
#pragma unroll
            for (int db = 0; db < 4; ++db) { const LAS unsigned short* vp = Vt + (16 * db + c) * 264 + 4 * g4;
                const u32x2 lo = *(const LAS u32x2*)(vp + 16 * (qg + t0)), hi = *(const LAS u32x2*)(vp + 16 * (qg + t1));
                const bf16x8_t vf = __builtin_bit_cast(bf16x8_t, (u32x4){lo.x, lo.y, hi.x, hi.y});
                o[db] = __builtin_amdgcn_mfma_f32_16x16x32_bf16(vf, pf, o[db], 0, 0, 0); } }
        bf16* hp = HB + row * 1024 + hq * 64 + 4 * g4;
#pragma unroll
        for (int db = 0; db < 4; ++db) { u32x2 w; w.x = pk2(o[db][0] * il, o[db][1] * il); w.y = pk2(o[db][2] * il, o[db][3] * il); *(u32x2*)(hp + 16 * db) = w; }
    }
    __syncthreads();
}

__device__ __forceinline__ void mlstm_local_phase(LAS unsigned char* lds, const int tid, int bx, int G, const bf16* Z, const float* IFb, bf16* CLT, float* Nst, float* GM) {
    const int lane = tid & 63, wave = tid >> 6;
    LAS unsigned short* KwT = (LAS unsigned short*)lds;
    LAS unsigned short* VT = KwT + 64 * 72;
    LAS float* wv_all = (LAS float*)(lds + (64 + 128) * 144);
    for (int base = bx; base < NUNIT_ML; base += 8 * G) {
        { const int uid = base + wave * G;
          if (uid < NUNIT_ML) { const int h = uid & 3; const size_t row0 = (size_t)(uid >> 2) * 64;
            const float ip = IFb[(row0 + lane) * 8 + h], fp = IFb[(row0 + lane) * 8 + 4 + h];
            const float lf = logsigmoidf_(fp);
            const float bc = wave_incl_sum(lf, lane);
            const float g = __shfl(bc, 63);
            const float a = g - bc + ip;
            const float ml = wave_max(a);
            wv_all[wave * 64 + lane] = expf(a - ml);
            if (lane == 0) { GM[uid * 4 + 0] = g; GM[uid * 4 + 1] = ml; } } }
        const int t = lane, ch = wave;
        u32x4 kq, v0, v1;
        { const int uid = base; const int h = uid & 3; const bf16* zr = Z + ((size_t)(uid >> 2) * 64 + t) * NIN;
          kq = *(const u32x4*)(zr + ZC_MK + h * 64 + ch * 8); v0 = *(const u32x4*)(zr + ZC_MV + h * 128 + ch * 8); v1 = *(const u32x4*)(zr + ZC_MV + h * 128 + 64 + ch * 8); }
        __syncthreads();
        for (int i = 0; i < 8; ++i) {
            const int uid = base + i * G; if (uid >= NUNIT_ML) break;
            {
                const float w = wv_all[i * 64 + t] * 0.125f; float f[8]; unpack8(kq, f);
#pragma unroll
                for (int e = 0; e < 8; ++e) KwT[(ch * 8 + e) * 72 + t] = (unsigned short)f2bf(w * f[e]);
                LAS unsigned short* p0 = VT + (ch * 8) * 72 + t; LAS unsigned short* p1 = VT + (64 + ch * 8) * 72 + t;
                p0[0 * 72] = (unsigned short)(v0.x & 0xffffu); p0[1 * 72] = (unsigned short)(v0.x >> 16); p0[2 * 72] = (unsigned short)(v0.y & 0xffffu); p0[3 * 72] = (unsigned short)(v0.y >> 16);
                p0[4 * 72] = (unsigned short)(v0.z & 0xffffu); p0[5 * 72] = (unsigned short)(v0.z >> 16); p0[6 * 72] = (unsigned short)(v0.w & 0xffffu); p0[7 * 72] = (unsigned short)(v0.w >> 16);
                p1[0 * 72] = (unsigned short)(v1.x & 0xffffu); p1[1 * 72] = (unsigned short)(v1.x >> 16); p1[2 * 72] = (unsigned short)(v1.y & 0xffffu); p1[3 * 72] = (unsigned short)(v1.y >> 16);
                p1[4 * 72] = (unsigned short)(v1.z & 0xffffu); p1[5 * 72] = (unsigned short)(v1.z >> 16); p1[6 * 72] = (unsigned short)(v1.w & 0xffffu); p1[7 * 72] = (unsigned short)(v1.w >> 16);
            }
            __syncthreads();
            { const int un = uid + G;
              if (i + 1 < 8 && un < NUNIT_ML) { const int h = un & 3; const bf16* zr = Z + ((size_t)(un >> 2) * 64 + t) * NIN;
                kq = *(const u32x4*)(zr + ZC_MK + h * 64 + ch * 8); v0 = *(const u32x4*)(zr + ZC_MV + h * 128 + ch * 8); v1 = *(const u32x4*)(zr + ZC_MV + h * 128 + 64 + ch * 8); } }
            {
                int c = lane & 15, g4 = lane >> 4; asm volatile("" : "+v"(c), "+v"(g4));
                const LAS unsigned short* vp = VT + (16 * wave + c) * 72 + 8 * g4;
                const bf16x8_t vb0 = *(const LAS bf16x8_t*)vp, vb1 = *(const LAS bf16x8_t*)(vp + 32);
                bf16* cbase = CLT + (size_t)uid * 8192 + (size_t)(16 * wave + c) * 64 + 4 * g4;
#pragma unroll
                for (int dt = 0; dt < 4; ++dt) { const LAS unsigned short* kp = KwT + (16 * dt + c) * 72 + 8 * g4;
                    const bf16x8_t ka0 = *(const LAS bf16x8_t*)kp, ka1 = *(const LAS bf16x8_t*)(kp + 32);
                    f32x4 a = (f32x4){0.f, 0.f, 0.f, 0.f};
                    a = __builtin_amdgcn_mfma_f32_16x16x32_bf16(ka0, vb0, a, 0, 0, 0);
                    a = __builtin_amdgcn_mfma_f32_16x16x32_bf16(ka1, vb1, a, 0, 0, 0);
                    u32x2 w; w.x = pk2(a[0], a[1]); w.y = pk2(a[2], a[3]); *(u32x2*)(cbase + 16 * dt) = w; }
            }
            if (tid < 64) { float s = 0.f; const LAS unsigned* kr = (const LAS unsigned*)(KwT + tid * 72);
#pragma unroll 8
                for (int t2 = 0; t2 < 32; ++t2) { const unsigned w2 = kr[t2]; s += bflo(w2) + bfhi(w2); }
                Nst[(size_t)uid * 64 + tid] = s; }
            __syncthreads();
        }
    }
}

__device__ __forceinline__ void mlstm_out_phase(LAS unsigned char* lds, const int tid, int bx, int G, const bf16* Z, const float* IFb, const bf16* CPT, const float* NP, const float* GM, const float* gain, bf16* HA) {
    const int lane = tid & 63, wave = tid >> 6;
    constexpr int QS = 0, KS = 9216, VTO = 18432, CTO = 36864, UB = 55296, VECALL = 2 * UB, VSTR = 384;
    constexpr int NPAIR = NUNIT_ML / 2;
    for (int base = bx; base < NPAIR; base += 4 * G) {
        { const int pair = base + (wave >> 1) * G, sub = wave & 1;
          if (pair < NPAIR) { const int uid = 2 * pair + sub, h = uid & 3; const size_t row0 = (size_t)(pair >> 1) * 64; LAS float* vec = (LAS float*)(lds + VECALL) + wave * VSTR;
            const float ip = IFb[(row0 + lane) * 8 + h], fp = IFb[(row0 + lane) * 8 + 4 + h];
            const float lf = logsigmoidf_(fp);
            const float bc = wave_incl_sum(lf, lane);
            const float pmx = wave_incl_max(ip - bc, lane);
            const float mprev = GM[uid * 4 + 2];
            const float ee = bc + mprev;
            const float mtv = fmaxf(bc + pmx, ee);
            vec[lane] = bc - mtv; vec[64 + lane] = ip - bc; vec[128 + lane] = expf(ee - mtv); vec[192 + lane] = NP[(size_t)uid * 64 + lane]; vec[256 + lane] = expf(-mtv); } }
        const int ts = tid >> 3, ch = tid & 7;
        u32x4 rq[2], rk[2], rv0[2], rv1[2], rc0[2], rc1[2];
#define MO_LOAD(pair_) do { const size_t row0_ = (size_t)((pair_) >> 1) * 64; \
            _Pragma("unroll") for (int u = 0; u < 2; ++u) { const int uid_ = 2 * (pair_) + u, h_ = uid_ & 3; const bf16* zr = Z + (row0_ + ts) * NIN; \
                rq[u] = *(const u32x4*)(zr + ZC_MQ + h_ * 64 + ch * 8); rk[u] = *(const u32x4*)(zr + ZC_MK + h_ * 64 + ch * 8); \
                { const bf16* zv = Z + (row0_ + lane) * NIN + ZC_MV + h_ * 128 + wave * 8; rv0[u] = *(const u32x4*)zv; rv1[u] = *(const u32x4*)(zv + 64); }     \
                const u32x4* cg = (const u32x4*)(CPT + (size_t)uid_ * 8192); rc0[u] = cg[tid]; rc1[u] = cg[tid + 512]; } } while (0)
        MO_LOAD(base);
        __syncthreads();
        for (int i = 0; i < 4; ++i) {
            const int pair = base + i * G; if (pair >= NPAIR) break;
            const size_t row0 = (size_t)(pair >> 1) * 64;
#pragma unroll
            for (int u = 0; u < 2; ++u) { LAS unsigned char* ub = lds + u * UB;
                *(LAS u32x4*)(ub + QS + ts * 144 + ch * 16) = rq[u];
                { float f[8]; unpack8(rk[u], f);
#pragma unroll
                  for (int e = 0; e < 8; ++e) f[e] *= 0.125f;
                  *(LAS u32x4*)(ub + KS + ts * 144 + ch * 16) = pack8f(f); }
                const u32x4 v0 = rv0[u], v1 = rv1[u];
                LAS unsigned short* p0 = (LAS unsigned short*)(ub + VTO) + (wave * 8) * 72 + lane; LAS unsigned short* p1 = p0 + 64 * 72;
                p0[0 * 72] = (unsigned short)(v0.x & 0xffffu); p0[1 * 72] = (unsigned short)(v0.x >> 16); p0[2 * 72] = (unsigned short)(v0.y & 0xffffu); p0[3 * 72] = (unsigned short)(v0.y >> 16);
                p0[4 * 72] = (unsigned short)(v0.z & 0xffffu); p0[5 * 72] = (unsigned short)(v0.z >> 16); p0[6 * 72] = (unsigned short)(v0.w & 0xffffu); p0[7 * 72] = (unsigned short)(v0.w >> 16);
                p1[0 * 72] = (unsigned short)(v1.x & 0xffffu); p1[1 * 72] = (unsigned short)(v1.x >> 16); p1[2 * 72] = (unsigned short)(v1.y & 0xffffu); p1[3 * 72] = (unsigned short)(v1.y >> 16);
                p1[4 * 72] = (unsigned short)(v1.z & 0xffffu); p1[5 * 72] = (unsigned short)(v1.z >> 16); p1[6 * 72] = (unsigned short)(v1.w & 0xffffu); p1[7 * 72] = (unsigned short)(v1.w >> 16);
                { const int e0 = tid >> 3, d0 = tid & 7; *(LAS u32x4*)(ub + CTO + e0 * 144 + d0 * 16) = rc0[u]; *(LAS u32x4*)(ub + CTO + (e0 + 64) * 144 + d0 * 16) = rc1[u]; }
            }
            __syncthreads();
            { const int pn = pair + G; if (i + 1 < 4 && pn < NPAIR) MO_LOAD(pn); }
            {
                const int sub = wave >> 2, tt = wave & 3; int c = lane & 15, g4 = lane >> 4; asm volatile("" : "+v"(c), "+v"(g4));
                const int uid = 2 * pair + sub, h = uid & 3; const LAS unsigned char* ub = lds + sub * UB; const LAS float* vec = (const LAS float*)(lds + VECALL) + (2 * i + sub) * VSTR;
                const int t = 16 * tt + c;
                const LAS unsigned char* qp = ub + QS + t * 144 + 16 * g4;
                const bf16x8_t qf0 = *(const LAS bf16x8_t*)qp, qf1 = *(const LAS bf16x8_t*)(qp + 64);
                const float bmt = vec[t], sint = vec[128 + t], emt = vec[256 + t];
                f32x4 wt[4]; float dsum = 0.f;
#pragma unroll
                for (int st = 0; st < 4; ++st) {
                    if (st <= tt) { const LAS unsigned char* kp = ub + KS + (16 * st + c) * 144 + 16 * g4;
                        const bf16x8_t ka0 = *(const LAS bf16x8_t*)kp, ka1 = *(const LAS bf16x8_t*)(kp + 64);
                        f32x4 a = (f32x4){0.f, 0.f, 0.f, 0.f};
                        a = __builtin_amdgcn_mfma_f32_16x16x32_bf16(ka0, qf0, a, 0, 0, 0);
                        a = __builtin_amdgcn_mfma_f32_16x16x32_bf16(ka1, qf1, a, 0, 0, 0);
                        const f32x4 us4 = *(const LAS f32x4*)(vec + 64 + 16 * st + 4 * g4);
#pragma unroll
                        for (int r = 0; r < 4; ++r) { const int s = 16 * st + 4 * g4 + r; const float w = (s <= t) ? __expf(bmt + us4[r]) * a[r] : 0.f; a[r] = w; dsum += w; }
                        wt[st] = a;
                    } else wt[st] = (f32x4){0.f, 0.f, 0.f, 0.f};
                }
                dsum += __shfl_xor(dsum, 16); dsum += __shfl_xor(dsum, 32);
                float qn = 0.f;
                { float f0[8], f1[8]; unpack8(__builtin_bit_cast(u32x4, qf0), f0); unpack8(__builtin_bit_cast(u32x4, qf1), f1);
                  const LAS f32x4* np = (const LAS f32x4*)(vec + 192 + 8 * g4); const f32x4 n0 = np[0], n1 = np[1], n2 = np[8], n3 = np[9];
                  qn = f0[0] * n0.x + f0[1] * n0.y + f0[2] * n0.z + f0[3] * n0.w + f0[4] * n1.x + f0[5] * n1.y + f0[6] * n1.z + f0[7] * n1.w
                     + f1[0] * n2.x + f1[1] * n2.y + f1[2] * n2.z + f1[3] * n2.w + f1[4] * n3.x + f1[5] * n3.y + f1[6] * n3.z + f1[7] * n3.w; }
                qn += __shfl_xor(qn, 16); qn += __shfl_xor(qn, 32);
                const float den = dsum + sint * qn; const float inv = 1.0f / fmaxf(fabsf(den), emt);
                u32x4 pwa, pwb;
                pwa.x = pk2(wt[0][0], wt[0][1]); pwa.y = pk2(wt[0][2], wt[0][3]); pwa.z = pk2(wt[1][0], wt[1][1]); pwa.w = pk2(wt[1][2], wt[1][3]);
                pwb.x = pk2(wt[2][0], wt[2][1]); pwb.y = pk2(wt[2][2], wt[2][3]); pwb.z = pk2(wt[3][0], wt[3][1]); pwb.w = pk2(wt[3][2], wt[3][3]);
                const bf16x8_t pf0 = __builtin_bit_cast(bf16x8_t, pwa), pf1 = __builtin_bit_cast(bf16x8_t, pwb);
                f32x4 hv[8]; float ssq = 0.f;
#pragma unroll
                for (int et = 0; et < 8; ++et) {
                    const LAS unsigned short* vp = (const LAS unsigned short*)(ub + VTO) + (16 * et + c) * 72 + 4 * g4;
                    const u32x2 l0 = *(const LAS u32x2*)vp, h0 = *(const LAS u32x2*)(vp + 16);
                    f32x4 a1 = (f32x4){0.f, 0.f, 0.f, 0.f};
                    a1 = __builtin_amdgcn_mfma_f32_16x16x32_bf16(__builtin_bit_cast(bf16x8_t, (u32x4){l0.x, l0.y, h0.x, h0.y}), pf0, a1, 0, 0, 0);
                    if (tt >= 2) { const u32x2 l1 = *(const LAS u32x2*)(vp + 32), h1 = *(const LAS u32x2*)(vp + 48);
                        a1 = __builtin_amdgcn_mfma_f32_16x16x32_bf16(__builtin_bit_cast(bf16x8_t, (u32x4){l1.x, l1.y, h1.x, h1.y}), pf1, a1, 0, 0, 0); }
                    const LAS unsigned char* cp = ub + CTO + (16 * et + c) * 144 + 16 * g4;
                    const bf16x8_t cf0 = *(const LAS bf16x8_t*)cp, cf1 = *(const LAS bf16x8_t*)(cp + 64);
                    f32x4 a2 = (f32x4){0.f, 0.f, 0.f, 0.f};
                    a2 = __builtin_amdgcn_mfma_f32_16x16x32_bf16(cf0, qf0, a2, 0, 0, 0);
                    a2 = __builtin_amdgcn_mfma_f32_16x16x32_bf16(cf1, qf1, a2, 0, 0, 0);
#pragma unroll
                    for (int r = 0; r < 4; ++r) { const float x = (a1[r] + sint * a2[r]) * inv; a1[r] = x; ssq += x * x; }
                    hv[et] = a1;
                }
                ssq += __shfl_xor(ssq, 16); ssq += __shfl_xor(ssq, 32);
                const float rn = 1.0f / sqrtf(ssq * (1.0f / 128.0f) + EPSF);
                const bf16* zo = Z + (row0 + t) * NIN + ZC_MO + h * 128 + 4 * g4; const float* gp = gain + h * 128 + 4 * g4; bf16* hp = HA + (row0 + t) * 1024 + h * 128 + 4 * g4;
#pragma unroll
                for (int et = 0; et < 8; ++et) { const u32x2 ow = *(const u32x2*)(zo + 16 * et); const f32x4 gn = *(const f32x4*)(gp + 16 * et);
                    u32x2 w; w.x = pk2(hv[et][0] * rn * gn.x * bflo(ow.x), hv[et][1] * rn * gn.y * bfhi(ow.x)); w.y = pk2(hv[et][2] * rn * gn.z * bflo(ow.y), hv[et][3] * rn * gn.w * bfhi(ow.y));
                    *(u32x2*)(hp + 16 * et) = w; }
            }
            __syncthreads();
        }
#undef MO_LOAD
    }
}

__device__ __forceinline__ pg8::RowTab build_rowtab(LAS unsigned char* lds, const int tid, const float* ss, const pg8::StaticOrder& S) {
    pg8::Unit u0; LAS float* tab = (LAS float*)(lds + RTAB_OFF); pg8::RowTab T; T.tab = tab; T.ss = ss; T.pm_hi = -1;
    if (S.next(0, u0)) { T.pm_hi = u0.pm | 8;
        const int slot = tid >> 8, r = tid & 255, pm = (u0.pm & ~8) + 8 * slot;
        float rs = 0.f;
        if (pm < S.nM) { const f32x4* p = (const f32x4*)(ss + ((size_t)pm * 256 + r) * 16); const f32x4 a = p[0], b = p[1], c = p[2], d = p[3];
            const float s = ((a[0] + a[1]) + (a[2] + a[3])) + ((b[0] + b[1]) + (b[2] + b[3])) + ((c[0] + c[1]) + (c[2] + c[3])) + ((d[0] + d[1]) + (d[2] + d[3]));
            rs = __builtin_amdgcn_rsqf(s * (1.0f / 1024.0f) + 1e-6f); }
        tab[tid] = rs; }
    __syncthreads();
    return T;
}

#ifndef SWA_UNIT
#define SWA_UNIT swa_unit_mfma
#endif
#ifndef REV_ORDER
#define REV_ORDER 1
#endif
#ifndef CVT_SPLIT
#define CVT_SPLIT 192
#endif
__global__ void __launch_bounds__(NWAVES * 64, 2) fwd_kernel(Args args_unused) {
    extern __shared__ __attribute__((aligned(16))) unsigned char lds_raw[];
    LAS unsigned char* lds = (LAS unsigned char*)lds_raw;
    const KArgs ka = (KArgs)__builtin_amdgcn_kernarg_segment_ptr();
    const int G = gridDim.x, bx = (int)blockIdx.x;
    for (int u = threadIdx.x; u < (LDS_BYTES - LDSCTL_OFF) / 4; u += NWAVES * 64) ((LAS unsigned*)(lds + LDSCTL_OFF))[u] = 0u;
    __syncthreads();
    volatile LAS unsigned* MISC = (volatile LAS unsigned*)(lds + MISC_OFF);
    const int lo = ka->ph_lo, hi = ka->ph_hi;
    XcdBarrier bar; bar.bar = (unsigned*)((gu32*)(ka->ws + WS_CTL) + CW_BAR) + ka->li * XCD_BAR_WORDS; bar.x = 0; bar.st = nullptr;
    if (hi - lo > 1) bar = xcd_barrier_post(bar.bar, MISC + 8);
#define IN(k) (lo <= (k) && (k) < hi)
#define SEAM(k) do { if (IN((k) + 1)) xcd_barrier(bar); } while (0)
#define WSP(T, off) ((T*)(ws + (off)))

    for (int l = 0; l < DEPTH; ++l) {
        const int pb = 12 * l;
        if (l == 0 && IN(pb + 0)) { phase_prologue(ka, lds, G); SEAM(pb + 0); }
        if (IN(pb + 1)) {
            PHASE_ENTRY(ka);
            pg8::Gemm g{WSP(bf16, WS_XB0), WSP(bf16, WS_W) + WO_UP1, M, NUP, DM}; pg8::StaticOrder S; S.init(M, NUP, G, bx); S.rev = REV_ORDER;
            pg8::EpiUp E{WSP(bf16, WS_H), FF, build_rowtab(lds, tid, WSP(float, WS_SSA), S)};
            pg8::gemm_phase<pg8::EpiUp, pg8::StaticOrder, true, true>(lds + RING_OFF, g, S, E);
            SEAM(pb + 1);
        }
        if (IN(pb + 2)) {
            PHASE_ENTRY(ka);
            pg8::Gemm g{WSP(bf16, WS_H), WSP(bf16, WS_W) + WO_DN1, M, DM, FF}; pg8::StaticOrder S; S.init(M, DM, G, bx);
            pg8::EpiRes<0> E{WSP(bf16, WS_XB0), WSP(bf16, WS_XB0), WSP(float, WS_SSB), 0.5f, nullptr, nullptr, nullptr};
            pg8::gemm_phase<pg8::EpiRes<0>, pg8::StaticOrder, true, true>(lds + RING_OFF, g, S, E);
            SEAM(pb + 2);
        }
        if (IN(pb + 3)) {
            PHASE_ENTRY(ka);
            pg8::Gemm g{WSP(bf16, WS_XB0), WSP(bf16, WS_W) + WO_IN, M, NIN, DM}; pg8::StaticOrder S; S.init(M, NIN, G, bx); S.rev = REV_ORDER;
            pg8::EpiIn E{WSP(bf16, WS_Z), NIN, build_rowtab(lds, tid, WSP(float, WS_SSB), S), WSP(float, WS_IF), A->in[I_B_I] + l * 4, A->in[I_B_F] + l * 4};
            pg8::gemm_phase<pg8::EpiIn, pg8::StaticOrder, true, true>(lds + RING_OFF, g, S, E);
            SEAM(pb + 3);
        }
        if (IN(pb + 4)) {
            { PHASE_ENTRY(ka);
              mlstm_local_phase(lds, tid, bx, G, WSP(bf16, WS_Z), WSP(float, WS_IF), WSP(bf16, WS_CST), WSP(float, WS_NST), WSP(float, WS_GM)); }
            { PHASE_ENTRY(ka);
              for (int u = bx; u < NUNIT_SW; u += G) SWA_UNIT(lds, tid, u, WSP(bf16, WS_Z), A->in[I_Q_NORM] + l * 64, A->in[I_K_NORM] + l * 64, A->in[I_SINKS] + l * 8, WSP(float, WS_BT), WSP(bf16, WS_HA) + 512); }
            SEAM(pb + 4);
        }
        if (IN(pb + 5)) {
            const int la = (l + 1 < DEPTH) ? l + 1 : -1; const int half = G >> 1;
            if (G >= 256 && bx >= half) convert_part(ka, lds, l, la, bx - half, G - half, 0, CVT_SPLIT);
            else { { PHASE_ENTRY(ka); mlstm_scan2(lds, tid, WSP(bf16, WS_CST), WSP(float, WS_NST), WSP(float, WS_GM), WSP(bf16, WS_CPT), WSP(float, WS_NP), G >= 256 ? half : G); }
                   if (G >= 256) convert_part(ka, lds, l, la, bx, half, CVT_SPLIT, 256); else convert_part(ka, lds, l, la, bx, G, 0, 256); }
            SEAM(pb + 5);
        }
        if (IN(pb + 6)) {
            PHASE_ENTRY(ka);
            mlstm_out_phase(lds, tid, bx, G, WSP(bf16, WS_Z), WSP(float, WS_IF), WSP(bf16, WS_CPT), WSP(float, WS_NP), WSP(float, WS_GM), A->in[I_ML_NORM] + l * 512, WSP(bf16, WS_HA));
            SEAM(pb + 6);
        }
        if (IN(pb + 7)) {
            PHASE_ENTRY(ka);
            pg8::Gemm g{WSP(bf16, WS_HA), WSP(bf16, WS_W) + WO_A, M, DM, DM}; pg8::StaticOrder S; S.init(M, DM, G, bx);
            pg8::EpiMixH E{WSP(bf16, WS_MIX), WSP(bf16, WS_Z), NIN};
            pg8::gemm_phase<pg8::EpiMixH, pg8::StaticOrder, true, true, true>(lds + RING_OFF, g, S, E);
            SEAM(pb + 7);
        }
        if (IN(pb + 8)) {
            PHASE_ENTRY(ka);
            pg8::Gemm g{WSP(bf16, WS_MIX), WSP(bf16, WS_W) + WO_OUT, M, DM, DM}; pg8::StaticOrder S; S.init(M, DM, G, bx); S.rev = REV_ORDER;
            pg8::EpiRes<0> E{WSP(bf16, WS_XB0), WSP(bf16, WS_XB0), WSP(float, WS_SSA), 1.0f, nullptr, nullptr, nullptr};
            pg8::gemm_phase<pg8::EpiRes<0>, pg8::StaticOrder, true, true>(lds + RING_OFF, g, S, E);
            SEAM(pb + 8);
        }
        if (IN(pb + 9)) {
            PHASE_ENTRY(ka);
            pg8::Gemm g{WSP(bf16, WS_XB0), WSP(bf16, WS_W) + WO_UP2, M, NUP, DM}; pg8::StaticOrder S; S.init(M, NUP, G, bx);
            pg8::EpiUp E{WSP(bf16, WS_H), FF, build_rowtab(lds, tid, WSP(float, WS_SSA), S)};
            pg8::gemm_phase<pg8::EpiUp, pg8::StaticOrder, true, true>(lds + RING_OFF, g, S, E);
            SEAM(pb + 9);
        }
        if (IN(pb + 10)) {
            PHASE_ENTRY(ka);
            pg8::Gemm g{WSP(bf16, WS_H), WSP(bf16, WS_W) + WO_DN2, M, DM, FF}; pg8::StaticOrder S; S.init(M, DM, G, bx); S.rev = REV_ORDER;
            pg8::EpiRes<0> E{WSP(bf16, WS_XB0), WSP(bf16, WS_XB1), WSP(float, WS_SSB), 0.5f, nullptr, nullptr, nullptr};
            pg8::gemm_phase<pg8::EpiRes<0>, pg8::StaticOrder, true, true>(lds + RING_OFF, g, S, E);
            SEAM(pb + 10);
        }
        if (IN(pb + 11)) {
            { PHASE_ENTRY(ka);
              int kpe = PD; asm volatile("" : "+s"(kpe));
              pg8::Gemm g{WSP(bf16, WS_PB), WSP(bf16, WS_W) + WO_PLE, M, DM, kpe}; pg8::StaticOrder S; S.init(M, DM, G, bx);
              pg8::EpiPlain E{WSP(bf16, WS_PE), DM};
              pg8::gemm_phase<pg8::EpiPlain, pg8::StaticOrder, true, true>(lds + RING_OFF, g, S, E); }
            { PHASE_ENTRY(ka);
              pg8::Gemm g{WSP(bf16, WS_XB1), WSP(bf16, WS_W) + WO_PG, M, DM, DM}; pg8::StaticOrder S; S.init(M, DM, G, bx);
              pg8::EpiRes<1> E{WSP(bf16, WS_XB1), WSP(bf16, WS_XB0), WSP(float, WS_SSA), 1.0f, WSP(float, WS_SSB), WSP(bf16, WS_PE), (l == DEPTH - 1) ? A->out : nullptr};
              pg8::gemm_phase<pg8::EpiRes<1>, pg8::StaticOrder, true, true>(lds + RING_OFF, g, S, E); }
            SEAM(pb + 11);
        }
    }
#undef IN
#undef SEAM
#undef WSP
}

extern "C" void kernel_launch(void* const* d_in, const int* in_sizes, int n_in, void* d_out, int out_size, void* d_ws, size_t ws_size, hipStream_t stream) {
    static int grid = 0;
    if (grid == 0) {
        if (n_in != 23 || in_sizes[0] != M * DM || out_size != M * DM || ws_size < WS_END) { fprintf(stderr, "kernel_launch: unexpected shapes: n_in %d in0 %d out %d ws %zu (need %zu)\n", n_in, n_in > 0 ? in_sizes[0] : -1, out_size, ws_size, (size_t)WS_END); grid = -1; return; }
        int dev = 0, cus = 0, per_cu = 0;
        if (hipGetDevice(&dev) != hipSuccess || hipDeviceGetAttribute(&cus, hipDeviceAttributeMultiprocessorCount, dev) != hipSuccess) { fprintf(stderr, "kernel_launch: device query failed\n"); grid = -1; return; }
        if (hipFuncSetAttribute((const void*)fwd_kernel, hipFuncAttributeMaxDynamicSharedMemorySize, LDS_BYTES) != hipSuccess) { fprintf(stderr, "kernel_launch: hipFuncSetAttribute failed\n"); grid = -1; return; }
        if (hipOccupancyMaxActiveBlocksPerMultiprocessor(&per_cu, (const void*)fwd_kernel, NWAVES * 64, LDS_BYTES) != hipSuccess || per_cu < 1) fprintf(stderr, "kernel_launch: occupancy query reports %d blocks per CU\n", per_cu);
        (void)hipGetLastError();
        grid = cus < 256 ? cus : 256;
        if (grid != 256) fprintf(stderr, "kernel_launch: %d CUs; this kernel is laid out for 256\n", cus);
    }
    if (grid < 0) return;
    if (hipMemsetAsync((char*)d_ws + WS_CTL, 0, CTL_ZERO_BYTES, stream) != hipSuccess) { fprintf(stderr, "kernel_launch: memset failed\n"); return; }
    Args a{};
    for (int i = 0; i < 23; ++i) a.in[i] = (const float*)d_in[i];
    a.out = (float*)d_out; a.ws = (unsigned char*)d_ws; a.pad = 0;
    constexpr int NL = MK_N_LAUNCHES;
    for (int li = 0; li < NL; ++li) {
        a.ph_lo = (int)((long)NPHASE * li / NL); a.ph_hi = (int)((long)NPHASE * (li + 1) / NL); a.li = li;
        hipLaunchKernelGGL(fwd_kernel, dim3(grid), dim3(NWAVES * 64), LDS_BYTES, stream, a);
        const hipError_t le = hipPeekAtLastError();
        if (le != hipSuccess) { fprintf(stderr, "kernel_launch: launch %d failed: %s\n", li, hipGetErrorName(le)); break; }
    }
}
```
